# Optimizing an MI355X kernel written in HIP

```python
import jax, jax.numpy as jnp
from jax import lax
import numpy as np

D_MODEL = 2048
BATCH = 16
SEQ = 256
DEPTH = 2
DEC_BATCH = 2
DEC_SEQ = 2048
PAST_LEN = 512

GRID_W = 64
N_EVEN = (DEPTH + 1) // 2
N_ODD = DEPTH // 2
A_HEADS = 8
A_DK = 128
A_DV = 128
A_KDIM = A_HEADS * A_DK
A_VDIM = A_HEADS * A_DV
B_HEADS = 4
B_DK = 128
B_DV = 256
B_KDIM = B_HEADS * B_DK
B_VDIM = B_HEADS * B_DV
GLA_RANK = 16
GLA_GATE_NORM = 16.0
CHUNK = 32
EVEN_SPLITS = (A_KDIM, A_KDIM, A_KDIM, A_VDIM, A_VDIM, B_KDIM, B_KDIM, B_VDIM, B_VDIM, GLA_RANK, GLA_RANK)
EVEN_IN = sum(EVEN_SPLITS)
LRU_WIDTH = D_MODEL
LRU_BLOCKS = 8
LRU_BW = LRU_WIDTH // LRU_BLOCKS
LRU_C = 8.0
CONV_W = 4
CONV_PAD_L = 2
D_FF = (8 * D_MODEL + 3 * 256 - 1) // (3 * 256) * 256
EPS = 1e-6

kernel_name = 'hybrid_hgrn2_gla_rglru_prefix_diffusion_step'


def _offsets(sizes):
    return [int(v) for v in np.cumsum(sizes)[:-1]]


def _rms_norm(x, g):
    xf = x.astype(jnp.float32)
    y = xf * lax.rsqrt(jnp.mean(xf * xf, axis=-1, keepdims=True) + EPS)
    return (y * g.astype(jnp.float32)).astype(x.dtype)


def _modulation(cvec, w, b):
    m = jax.nn.silu(cvec) @ w + b
    return [u[:, None, :] for u in jnp.split(m, 6, axis=-1)]


def _chunk_gla(q, k, v, log_a, s0):
    bsz, t, h, _ = q.shape
    dv = v.shape[-1]
    n = t // CHUNK
    f32 = jnp.float32

    def to_chunks(z):
        return jnp.moveaxis(z.astype(f32).reshape(bsz, n, CHUNK, h, z.shape[-1]), 1, 0)

    qc, kc, vc, gc = to_chunks(q), to_chunks(k), to_chunks(v), to_chunks(log_a)
    causal = jnp.tril(jnp.ones((CHUNK, CHUNK), dtype=bool))

    def step(s, inp):
        qi, ki, vi, gi = inp
        b = jnp.cumsum(gi, axis=1)
        q_dec = qi * jnp.exp(b)
        k_inv = ki * jnp.exp(-b)
        att = jnp.where(causal, jnp.einsum('bihd,bjhd->bhij', q_dec, k_inv), 0.0)
        o = jnp.einsum('bihd,bhdv->bihv', q_dec, s) + jnp.einsum('bhij,bjhv->bihv', att, vi)
        b_last = b[:, -1]
        k_tail = ki * jnp.exp(b_last[:, None] - b)
        s = jnp.exp(b_last)[..., None] * s + jnp.einsum('bjhd,bjhv->bhdv', k_tail, vi)
        return s, o

    s_fin, o = lax.scan(step, s0.astype(f32), (qc, kc, vc, gc))
    return jnp.moveaxis(o, 0, 1).reshape(bsz, t, h, dv), s_fin


def _bidir_gla(q, k_f, k_b, v, g_f, g_b, s0):
    rev = lambda z: jnp.flip(z, axis=1)
    o_f, s_f = _chunk_gla(q, k_f, v, g_f, s0[:, 0])
    o_b, s_b = _chunk_gla(rev(q), rev(k_b), rev(v), rev(g_b), s0[:, 1])
    return o_f + rev(o_b), jnp.stack([s_f, s_b], axis=1)


def _gated_head_norm(o, gate, gain):
    bsz, t, h, dv = o.shape
    o = o * lax.rsqrt(jnp.mean(o * o, axis=-1, keepdims=True) + EPS) * gain.astype(jnp.float32)
    return o.reshape(bsz, t, h * dv) * jax.nn.silu(gate.astype(jnp.float32))


def _even_mixer(h, s_a0, s_b0, lb, w_in, w_alpha, b_alpha, a_gain, b_gain, w_out):
    bsz, t, _ = h.shape
    f32 = jnp.float32
    aq, af_f, af_b, ai, ag, bq, bk, bv, bg, blr_f, blr_b = jnp.split(h @ w_in, _offsets(EVEN_SPLITS), axis=-1)
    hd = lambda u, n: u.astype(f32).reshape(bsz, t, n, -1)
    lbf = lb.astype(f32)
    f_f = lbf + (1.0 - lbf) * jax.nn.sigmoid(af_f.astype(f32))
    f_b = lbf + (1.0 - lbf) * jax.nn.sigmoid(af_b.astype(f32))
    qa = hd(aq, A_HEADS) * (A_DK ** -0.5)
    o_a, s_a = _bidir_gla(qa, hd(1.0 - f_f, A_HEADS), hd(1.0 - f_b, A_HEADS), hd(ai, A_HEADS),
                          hd(jnp.log(f_f), A_HEADS), hd(jnp.log(f_b), A_HEADS), s_a0)
    g_f = jax.nn.log_sigmoid((blr_f @ w_alpha[0] + b_alpha[0]).astype(f32)) / GLA_GATE_NORM
    g_b = jax.nn.log_sigmoid((blr_b @ w_alpha[1] + b_alpha[1]).astype(f32)) / GLA_GATE_NORM
    qb = hd(bq, B_HEADS) * (B_DK ** -0.5)
    kb = hd(bk, B_HEADS)
    o_b, s_b = _bidir_gla(qb, kb, kb, hd(bv, B_HEADS), hd(g_f, B_HEADS), hd(g_b, B_HEADS), s_b0)
    merged = jnp.concatenate([_gated_head_norm(o_a, ag, a_gain), _gated_head_norm(o_b, bg, b_gain)], axis=-1)
    return merged.astype(h.dtype) @ w_out, s_a, s_b


def _centred_dwconv(u, w, b):
    n = u.shape[1]
    up = jnp.pad(u, ((0, 0), (CONV_PAD_L, CONV_W - 1 - CONV_PAD_L), (0, 0)))
    out = b
    for j in range(CONV_W):
        out = out + up[:, j:j + n] * w[j]
    return out


def _rglru(xc, w_rg, b_rg, w_ig, b_ig, lam, h0):
    bsz, t, _ = xc.shape
    f32 = jnp.float32
    xb = xc.reshape(bsz, t, LRU_BLOCKS, LRU_BW)
    r = jax.nn.sigmoid(jnp.einsum('btnc,ncd->btnd', xb, w_rg.astype(f32)).reshape(bsz, t, -1) + b_rg.astype(f32))
    i = jax.nn.sigmoid(jnp.einsum('btnc,ncd->btnd', xb, w_ig.astype(f32)).reshape(bsz, t, -1) + b_ig.astype(f32))
    log_a = -LRU_C * r * jax.nn.softplus(-lam.astype(f32))
    a = jnp.exp(log_a)
    u = jnp.sqrt(-jnp.expm1(2.0 * log_a)) * (i * xc)

    def combine(left, right):
        a1, b1 = left
        a2, b2 = right
        return a1 * a2, a2 * b1 + b2

    a_cum, hs = lax.associative_scan(combine, (a, u), axis=1)
    hs = hs + a_cum * h0.astype(f32)[:, None, :]
    return hs, hs[:, -1]


def _odd_mixer(h, s0, latent, w_in, conv_w, conv_b, rg_w, rg_b, ig_w, ig_b, lam, w_out):
    bsz, t, _ = h.shape
    f32 = jnp.float32
    xr, gate = jnp.split(h @ w_in, 2, axis=-1)
    if latent:
        rows = t // GRID_W
        xc = _centred_dwconv(xr.reshape(bsz * rows, GRID_W, LRU_WIDTH), conv_w, conv_b).reshape(bsz, t, LRU_WIDTH)
    else:
        xc = _centred_dwconv(xr, conv_w, conv_b)
    xc = xc.astype(f32)
    y_f, s_f = _rglru(xc, rg_w[0], rg_b[0], ig_w[0], ig_b[0], lam[0], s0[:, 0])
    y_b, s_b = _rglru(jnp.flip(xc, axis=1), rg_w[1], rg_b[1], ig_w[1], ig_b[1], lam[1], s0[:, 1])
    y = (y_f + jnp.flip(y_b, axis=1)) * jax.nn.gelu(gate.astype(f32), approximate=True)
    return y.astype(h.dtype) @ w_out, jnp.stack([s_f, s_b], axis=1)


def _swiglu(h, w_in, w_out):
    gt, up = jnp.split(h @ w_in, 2, axis=-1)
    return (jax.nn.silu(gt) * up) @ w_out


def _trunk(x, cvec, s_hgrn, s_gla, s_lru, latent, p):
    lb_all = jnp.cumsum(jax.nn.softmax(p['hgrn_lower_bounds'].astype(jnp.float32), axis=0), axis=0)
    out_h, out_g, out_r = [], [], []
    for l in range(DEPTH):
        sh1, sc1, g1, sh2, sc2, g2 = _modulation(cvec, p['w_mod'][l], p['b_mod'][l])
        h = _rms_norm(x, p['norm1_g'][l]) * (1 + sc1) + sh1
        e = l // 2
        if l % 2 == 0:
            mix, sa, sb = _even_mixer(h, s_hgrn[:, e], s_gla[:, e], lb_all[l], p['even_w_in'][e],
                                      p['gla_w_alpha'][e], p['gla_b_alpha'][e], p['hgrn_norm_g'][e],
                                      p['gla_norm_g'][e], p['even_w_out'][e])
            out_h.append(sa)
            out_g.append(sb)
        else:
            mix, sr = _odd_mixer(h, s_lru[:, e], latent, p['odd_w_in'][e], p['conv_w'][e], p['conv_b'][e],
                                 p['rg_w'][e], p['rg_b'][e], p['ig_w'][e], p['ig_b'][e],
                                 p['lru_lambda'][e], p['odd_w_out'][e])
            out_r.append(sr)
        x = x + g1 * mix
        h = _rms_norm(x, p['norm2_g'][l]) * (1 + sc2) + sh2
        x = x + g2 * _swiglu(h, p['ffn_w_in'][l], p['ffn_w_out'][l])
    y = _rms_norm(x, p['final_norm_g'])
    return y, jnp.stack(out_h, axis=1), jnp.stack(out_g, axis=1), jnp.stack(out_r, axis=1)


def setup_inputs(seed: int = 0) -> dict:
    key = jax.random.key(seed)
    ks = iter(jax.random.split(key, 40))
    f32 = jnp.float32
    nrm = lambda shape, scale: scale * jax.random.normal(next(ks), shape, f32)
    D = D_MODEL
    x_prompt = nrm((BATCH, SEQ, D), 1.0)
    x_sample = nrm((DEC_BATCH, DEC_SEQ, D), 1.0)
    state_hgrn = nrm((DEC_BATCH, N_EVEN, 2, A_HEADS, A_DK, A_DV), 0.5)
    state_gla = nrm((DEC_BATCH, N_EVEN, 2, B_HEADS, B_DK, B_DV), 1.0)
    state_rglru = nrm((DEC_BATCH, N_ODD, 2, LRU_WIDTH), 0.5)
    c = nrm((DEC_BATCH, D), 1.0)
    c_ctx = nrm((D,), 1.0)
    norm1_g = 1.0 + nrm((DEPTH, D), 0.05)
    norm2_g = 1.0 + nrm((DEPTH, D), 0.05)
    w_mod = nrm((DEPTH, D, 6 * D), D ** -0.5)
    b_mod = nrm((DEPTH, 6 * D), 0.01)
    ffn_w_in = nrm((DEPTH, D, 2 * D_FF), D ** -0.5)
    ffn_w_out = nrm((DEPTH, D_FF, D), D_FF ** -0.5)
    hgrn_lower_bounds = nrm((DEPTH + 1, A_KDIM), 0.1)
    even_w_in = nrm((N_EVEN, D, EVEN_IN), D ** -0.5)
    gla_w_alpha = nrm((N_EVEN, 2, GLA_RANK, B_KDIM), GLA_RANK ** -0.5)
    gla_b_alpha = nrm((N_EVEN, 2, B_KDIM), 0.1)
    hgrn_norm_g = 1.0 + nrm((N_EVEN, A_DV), 0.05)
    gla_norm_g = 1.0 + nrm((N_EVEN, B_DV), 0.05)
    even_w_out = nrm((N_EVEN, A_VDIM + B_VDIM, D), (A_VDIM + B_VDIM) ** -0.5)
    odd_w_in = nrm((N_ODD, D, 2 * LRU_WIDTH), D ** -0.5)
    conv_w = nrm((N_ODD, CONV_W, LRU_WIDTH), CONV_W ** -0.5)
    conv_b = nrm((N_ODD, LRU_WIDTH), 0.01)
    rg_w = nrm((N_ODD, 2, LRU_BLOCKS, LRU_BW, LRU_BW), LRU_BW ** -0.5)
    rg_b = nrm((N_ODD, 2, LRU_WIDTH), 0.01)
    ig_w = nrm((N_ODD, 2, LRU_BLOCKS, LRU_BW, LRU_BW), LRU_BW ** -0.5)
    ig_b = nrm((N_ODD, 2, LRU_WIDTH), 0.01)
    a_c = jax.random.uniform(next(ks), (N_ODD, 2, LRU_WIDTH), f32, 0.9, 0.999)
    a_base = a_c ** (1.0 / LRU_C)
    lru_lambda = jnp.log(a_base) - jnp.log1p(-a_base)
    odd_w_out = nrm((N_ODD, LRU_WIDTH, D), LRU_WIDTH ** -0.5)
    final_norm_g = 1.0 + nrm((D,), 0.05)
    return {'x_prompt': x_prompt, 'x_sample': x_sample, 'state_hgrn': state_hgrn, 'state_gla': state_gla,
            'state_rglru': state_rglru, 'c': c, 'c_ctx': c_ctx, 'norm1_g': norm1_g, 'norm2_g': norm2_g,
            'w_mod': w_mod, 'b_mod': b_mod, 'ffn_w_in': ffn_w_in, 'ffn_w_out': ffn_w_out,
            'hgrn_lower_bounds': hgrn_lower_bounds, 'even_w_in': even_w_in, 'gla_w_alpha': gla_w_alpha,
            'gla_b_alpha': gla_b_alpha, 'hgrn_norm_g': hgrn_norm_g, 'gla_norm_g': gla_norm_g,
            'even_w_out': even_w_out, 'odd_w_in': odd_w_in, 'conv_w': conv_w, 'conv_b': conv_b,
            'rg_w': rg_w, 'rg_b': rg_b, 'ig_w': ig_w, 'ig_b': ig_b, 'lru_lambda': lru_lambda,
            'odd_w_out': odd_w_out, 'final_norm_g': final_norm_g}


def reference(x_prompt, x_sample, state_hgrn, state_gla, state_rglru, c, c_ctx, norm1_g, norm2_g, w_mod, b_mod,
              ffn_w_in, ffn_w_out, hgrn_lower_bounds, even_w_in, gla_w_alpha, gla_b_alpha, hgrn_norm_g,
              gla_norm_g, even_w_out, odd_w_in, conv_w, conv_b, rg_w, rg_b, ig_w, ig_b, lru_lambda, odd_w_out,
              final_norm_g):
    p = dict(norm1_g=norm1_g, norm2_g=norm2_g, w_mod=w_mod, b_mod=b_mod, ffn_w_in=ffn_w_in,
             ffn_w_out=ffn_w_out, hgrn_lower_bounds=hgrn_lower_bounds, even_w_in=even_w_in,
             gla_w_alpha=gla_w_alpha, gla_b_alpha=gla_b_alpha, hgrn_norm_g=hgrn_norm_g, gla_norm_g=gla_norm_g,
             even_w_out=even_w_out, odd_w_in=odd_w_in, conv_w=conv_w, conv_b=conv_b, rg_w=rg_w, rg_b=rg_b,
             ig_w=ig_w, ig_b=ig_b, lru_lambda=lru_lambda, odd_w_out=odd_w_out, final_norm_g=final_norm_g)
    bp = x_prompt.shape[0]
    z_hgrn = jnp.zeros((bp, N_EVEN, 2, A_HEADS, A_DK, A_DV), jnp.float32)
    z_gla = jnp.zeros((bp, N_EVEN, 2, B_HEADS, B_DK, B_DV), jnp.float32)
    z_lru = jnp.zeros((bp, N_ODD, 2, LRU_WIDTH), jnp.float32)
    y_prompt, new_hgrn, new_gla, new_lru = _trunk(x_prompt, c_ctx[None, :], z_hgrn, z_gla, z_lru, False, p)
    y_sample = _trunk(x_sample, c, state_hgrn, state_gla, state_rglru, True, p)[0]
    dt = x_prompt.dtype
    return (y_prompt, y_sample, new_hgrn.astype(dt), new_gla.astype(dt), new_lru.astype(dt))
```

```cpp
#include <hip/hip_runtime.h>
#include <hip/hip_cooperative_groups.h>
#include <cstdio>
namespace cg = cooperative_groups;

#ifndef PHMASK
#define PHMASK 0xfffff
#endif
#define EN(k) ((PHMASK >> (k)) & 1)
#ifndef ONE_LAUNCH
#define ONE_LAUNCH 1
#endif

#define LAS __attribute__((address_space(3)))
typedef unsigned short bf16_t;
typedef short bf16x8 __attribute__((ext_vector_type(8)));
typedef float f32x4 __attribute__((ext_vector_type(4)));
typedef unsigned u32x4 __attribute__((ext_vector_type(4)));
typedef unsigned u32x2 __attribute__((ext_vector_type(2)));

constexpr int D = 2048, MTOK = 8192, NPR = 4096;
constexpr int DFF = 5632, NEVEN = 8224, NEVENP = 8448;
constexpr int NTHREADS = 512;
constexpr int LDS_BYTES = 131072 + 16;
constexpr int NPHASE = 20;

constexpr size_t SZ_WT_EVEN_IN = (size_t)NEVENP * D * 2, SZ_WT_SQ = (size_t)D * D * 2, SZ_WT_FFN_IN = (size_t)2 * DFF * D * 2, SZ_WT_FFN_OUT = (size_t)D * DFF * 2;
constexpr size_t WS_WT_EVEN_IN = 0;
constexpr size_t WS_WT_EVEN_OUT = WS_WT_EVEN_IN + SZ_WT_EVEN_IN;
constexpr size_t WS_WT_FFN_IN0 = WS_WT_EVEN_OUT + SZ_WT_SQ;
constexpr size_t WS_WT_FFN_OUT0 = WS_WT_FFN_IN0 + SZ_WT_FFN_IN;
constexpr size_t WS_WT_FFN_IN1 = WS_WT_FFN_OUT0 + SZ_WT_FFN_OUT;
constexpr size_t WS_WT_FFN_OUT1 = WS_WT_FFN_IN1 + SZ_WT_FFN_IN;
constexpr size_t WS_WT_ODD_IN = WS_WT_FFN_OUT1 + SZ_WT_FFN_OUT;
constexpr size_t WS_WT_GATE = WS_WT_ODD_IN + (size_t)4096 * D * 2;
constexpr size_t WS_WT_ODD_OUT = WS_WT_GATE + (size_t)8192 * 256 * 2;
constexpr size_t WS_MOD = WS_WT_ODD_OUT + SZ_WT_SQ;
constexpr size_t SZ_MOD = (size_t)2 * 3 * 12288 * 4;
constexpr size_t WS_LB = WS_MOD + SZ_MOD;
constexpr size_t WS_BAR = WS_LB + 4096;
constexpr size_t SZ_BAR = 16384;
constexpr size_t WS_NS = WS_BAR + SZ_BAR;
constexpr size_t SZ_NS_CNT = 4 * 32 * 64 * 4;
constexpr size_t SZ_NS = SZ_NS_CNT + (size_t)4 * 8192 * 8 * 4;
constexpr size_t WS_HBUF = WS_NS + SZ_NS;
constexpr size_t SZ_ACT_F32 = (size_t)MTOK * D * 4, SZ_ACT_BF = (size_t)MTOK * D * 2;
constexpr size_t WS_XBUF = WS_HBUF + SZ_ACT_BF;
constexpr size_t WS_ACT = WS_XBUF + SZ_ACT_F32;
constexpr size_t WS_R = WS_ACT + (size_t)MTOK * DFF * 2;
constexpr size_t WS_PB = WS_R;
constexpr size_t WS_PG = WS_PB + (size_t)MTOK * 8192 * 2;
constexpr size_t WS_PL = WS_PG + SZ_ACT_F32;
constexpr size_t WS_OF = WS_PL + (size_t)MTOK * 32 * 4;
constexpr size_t WS_OB = WS_OF + SZ_ACT_F32;
constexpr size_t WS_R_END0 = WS_OB + SZ_ACT_F32;
constexpr size_t WS_XR = WS_R;
constexpr size_t WS_GG = WS_XR + SZ_ACT_F32;
constexpr size_t WS_XCB = WS_GG + SZ_ACT_BF;
constexpr size_t WS_UF = WS_XCB + SZ_ACT_BF;
constexpr size_t WS_AB = WS_UF + SZ_ACT_F32;
constexpr size_t WS_UB = WS_AB + SZ_ACT_F32;
constexpr size_t WS_R_END1 = WS_UB + SZ_ACT_F32;
constexpr size_t WS_END = (WS_R_END0 > WS_R_END1 ? WS_R_END0 : WS_R_END1);
constexpr size_t WS_XC = WS_WT_EVEN_IN;
static_assert(WS_WT_FFN_IN1 - WS_WT_EVEN_IN >= SZ_ACT_F32, "xc alias");

constexpr size_t OUT_Y = 0, OUT_H = (size_t)MTOK * D, OUT_G = OUT_H + (size_t)16 * 2 * 8 * 128 * 128, OUT_R = OUT_G + (size_t)16 * 2 * 4 * 128 * 256;

struct Params { const float* in[30]; float* out; unsigned char* ws; int ph_lo, ph_hi; };

__device__ __forceinline__ const float* in_ptr_(int byte_off) {
    const char* ka = (const char*)__builtin_amdgcn_kernarg_segment_ptr(); unsigned long long v;
    asm volatile("s_load_dwordx2 %0, %1, %2\n\ts_waitcnt lgkmcnt(0)" : "=s"(v) : "s"(ka), "i"(byte_off) : "memory");
    return (const float*)v;
}
#define INP(k) in_ptr_((k) * 8)
typedef __bf16 bf16v2_t __attribute__((ext_vector_type(2)));
typedef float f32x2_t __attribute__((ext_vector_type(2)));
__device__ __forceinline__ unsigned cvt_pk_bf16(float lo, float hi) { const f32x2_t v = {lo, hi}; const bf16v2_t b = __builtin_convertvector(v, bf16v2_t); return __builtin_bit_cast(unsigned, b); }
__device__ __forceinline__ float bf2f(bf16_t b) { return __uint_as_float(((unsigned)b) << 16); }
__device__ __forceinline__ float sigm(float x) { return __builtin_amdgcn_rcpf(1.f + __expf(-x)); }
__device__ __forceinline__ float gelu_tanh(float x) { const float u = 0.7978845608028654f * (x + 0.044715f * x * x * x); const float t = 1.f - 2.f * __builtin_amdgcn_rcpf(1.f + __expf(2.f * u)); return 0.5f * x * (1.f + t); }
__device__ __forceinline__ float wave_sum(float v) { for (int o = 32; o >= 1; o >>= 1) v += __shfl_xor(v, o); return v; }
__device__ __forceinline__ int row_cvec(int row) { return row < NPR ? 0 : 1 + ((row - NPR) >> 11); }

namespace pg8 {
constexpr int BM = 256, BK = 64, HALF = 128, HTB = HALF * BK * 2, NXCD = 8, WGM = 8;
__device__ __forceinline__ int lds_byte(int r, int c) { const int st = (r >> 4) * 2 + (c >> 5), rr = r & 15, cc = c & 31, ob = rr * 64 + cc * 2; return st * 1024 + (ob ^ (((ob >> 9) & 1) << 5)); }
__device__ __forceinline__ void stage_rc(int b, int& R, int& C) { const int st = b / 1024, sb = b % 1024, swz = sb ^ (((sb >> 9) & 1) << 5); R = (st >> 1) * 16 + swz / 64; C = (st & 1) * 32 + (swz % 64) / 2; }
struct Unit { int pm, pn; };
struct Gemm { const bf16_t* A; const bf16_t* Bt; int M, N, K, lda, amode; };
struct StaticOrder {
    int nM, nN, nwg, G, c;
    __device__ void init(int M, int N, int G_, int c_) { nM = M / BM; nN = N / BM; nwg = nM * nN; G = G_; c = c_; }
    __device__ bool next(int i, Unit& u) const {
        const long L = (long)i * G + c; if (L >= nwg) return false;
        int wgid = (int)L; { const int q = nwg / NXCD, r = nwg % NXCD, xcd = wgid % NXCD, off = wgid / NXCD; wgid = (xcd < r ? xcd * (q + 1) : r * (q + 1) + (xcd - r) * q) + off; }
        const int nig = WGM * nN, gid = wgid / nig, fm = gid * WGM, gsz = (nM - fm) < WGM ? (nM - fm) : WGM;
        u.pm = fm + ((wgid % nig) % gsz); u.pn = (wgid % nig) / gsz; return true;
    }
};
__device__ __forceinline__ const char* a_base(const Gemm& g, const Unit& u) {
    size_t off = (size_t)u.pm * BM * g.lda;
    if (g.amode == 1) off += (size_t)((u.pn & 15) >> 1) * 256;
    return (const char*)g.A + off * 2;
}

template <class Epi>
__device__ __forceinline__ void gemm_phase(LAS unsigned char* lds, const Gemm g, const StaticOrder& S, const Epi& E) {
    const int tid = threadIdx.x, wid = __builtin_amdgcn_readfirstlane(tid >> 6), lane = tid & 63, wr = wid >> 2, wc = wid & 3, fr = lane & 15, fq = lane >> 4;
    const int K = g.K, nt = K / BK;
    unsigned voffA[2], voffB[2];
#pragma unroll
    for (int i = 0; i < 2; ++i) { int R, C; stage_rc(tid * 16 + i * 8192, R, C);
        voffA[i] = (unsigned)(R * g.lda + C) * 2u; voffB[i] = (unsigned)(R * K + C) * 2u; }
    const size_t kstep = (size_t)(BK * 2);
    const size_t hstepA = (size_t)HALF * g.lda * 2, hstepB = (size_t)HALF * K * 2;
    const unsigned ldsw = (unsigned)wid * 1024u;
    const int aoff = lds_byte(wr * 64 + fr, fq * 8), boff = lds_byte(wc * 32 + fr, fq * 8);
#define PG8_SA(b, h) (((b) * 2 + (h)) * HTB)
#define PG8_SB(b, h) ((4 + (b) * 2 + (h)) * HTB)
#define PG8_STAGE(bufoff, gbase, voff) do { _Pragma("unroll") for (int _i = 0; _i < 2; ++_i) \
        __builtin_amdgcn_global_load_lds((const unsigned*)((const char*)(gbase) + (voff)[_i]), (LAS unsigned*)(lds + (bufoff) + ldsw + _i * 8192), 16, 0, 0); } while (0)
#define PG8_LDA(dst, b, h) do { _Pragma("unroll") for (int m = 0; m < 4; ++m) _Pragma("unroll") for (int k = 0; k < 2; ++k) dst[m][k] = *(const LAS bf16x8*)(lds + PG8_SA(b, h) + aoff + m * 2048 + k * 1024); } while (0)
#define PG8_LDB(dst, b, h) do { _Pragma("unroll") for (int n = 0; n < 2; ++n) _Pragma("unroll") for (int k = 0; k < 2; ++k) dst[n][k] = *(const LAS bf16x8*)(lds + PG8_SB(b, h) + boff + n * 2048 + k * 1024); } while (0)
#define PG8_MMA(ai, bj, At, Bt) do { __builtin_amdgcn_s_setprio(1); _Pragma("unroll") for (int m = 0; m < 4; ++m) _Pragma("unroll") for (int n = 0; n < 2; ++n) _Pragma("unroll") for (int k = 0; k < 2; ++k) \
        acc[ai][bj][m][n] = __builtin_amdgcn_mfma_f32_16x16x32_bf16(Bt[n][k], At[m][k], acc[ai][bj][m][n], 0, 0, 0); __builtin_amdgcn_s_setprio(0); } while (0)
#define PG8_WAIT_V(n) asm volatile("s_waitcnt vmcnt(" #n ")" ::: "memory")
#define PG8_WAIT_L(n) asm volatile("s_waitcnt lgkmcnt(" #n ")" ::: "memory")
#define PG8_BAR __builtin_amdgcn_s_barrier()
#define PG8_SCHED __builtin_amdgcn_sched_barrier(0)
    Unit cur, nxt; int ui = 0;
    if (!S.next(0, cur)) return;
    f32x4 acc[2][2][4][2];
#pragma unroll
    for (int a = 0; a < 2; ++a)
#pragma unroll
        for (int b = 0; b < 2; ++b)
#pragma unroll
            for (int m = 0; m < 4; ++m)
#pragma unroll
                for (int n = 0; n < 2; ++n) acc[a][b][m][n] = (f32x4){0.f, 0.f, 0.f, 0.f};
    bf16x8 At[4][2], B0[2][2], B1[2][2];
    const char* cA = a_base(g, cur); const char* cB = (const char*)g.Bt + (size_t)cur.pn * BM * K * 2;
    PG8_STAGE(PG8_SB(0, 0), cB, voffB); PG8_STAGE(PG8_SA(0, 0), cA, voffA); PG8_STAGE(PG8_SB(0, 1), cB + hstepB, voffB); PG8_STAGE(PG8_SA(0, 1), cA + hstepA, voffA);
    if (wr == 1) PG8_BAR;
    PG8_WAIT_V(4); PG8_BAR;
    PG8_STAGE(PG8_SB(1, 0), cB + kstep, voffB); PG8_STAGE(PG8_SA(1, 0), cA + kstep, voffA); PG8_STAGE(PG8_SB(1, 1), cB + hstepB + kstep, voffB);
    PG8_WAIT_V(6); PG8_BAR;
    for (;;) {
        const bool has_next = S.next(ui + 1, nxt);
        const char* nA = has_next ? a_base(g, nxt) : cA; const char* nB = has_next ? (const char*)g.Bt + (size_t)nxt.pn * BM * K * 2 : cB;
#pragma unroll 1
        for (int t = 0; t < nt; t += 2) {
            const bool last = (t == nt - 2);
            const char* a1 = cA + (size_t)(t + 1) * kstep;
            const char* a2 = last ? nA : cA + (size_t)(t + 2) * kstep; const char* b2 = last ? nB : cB + (size_t)(t + 2) * kstep;
            const char* a3 = a2 + kstep; const char* b3 = b2 + kstep;
            PG8_LDB(B0, 0, 0); PG8_SCHED; PG8_LDA(At, 0, 0); PG8_STAGE(PG8_SA(1, 1), a1 + hstepA, voffA);
            PG8_WAIT_L(8); PG8_BAR; PG8_WAIT_L(0); PG8_MMA(0, 0, At, B0); PG8_BAR; PG8_SCHED;
            PG8_LDB(B1, 0, 1); PG8_STAGE(PG8_SB(0, 0), b2, voffB);
            PG8_BAR; PG8_WAIT_L(0); PG8_MMA(0, 1, At, B1); PG8_BAR;
            PG8_LDA(At, 0, 1); PG8_STAGE(PG8_SA(0, 0), a2, voffA);
            PG8_BAR; PG8_WAIT_L(0); PG8_MMA(1, 0, At, B0); PG8_BAR; PG8_SCHED;
            PG8_STAGE(PG8_SB(0, 1), b2 + hstepB, voffB);
            PG8_WAIT_V(6); PG8_BAR; PG8_MMA(1, 1, At, B1); PG8_BAR;
            PG8_LDB(B0, 1, 0); PG8_SCHED; PG8_LDA(At, 1, 0); PG8_STAGE(PG8_SA(0, 1), a2 + hstepA, voffA);
            PG8_WAIT_L(8); PG8_BAR; PG8_WAIT_L(0); PG8_MMA(0, 0, At, B0); PG8_BAR; PG8_SCHED;
            PG8_LDB(B1, 1, 1); PG8_STAGE(PG8_SB(1, 0), b3, voffB);
            PG8_BAR; PG8_WAIT_L(0); PG8_MMA(0, 1, At, B1); PG8_BAR;
            PG8_LDA(At, 1, 1); PG8_STAGE(PG8_SA(1, 0), a3, voffA);
            PG8_BAR; PG8_WAIT_L(0); PG8_MMA(1, 0, At, B0); PG8_BAR; PG8_SCHED;
            PG8_STAGE(PG8_SB(1, 1), b3 + hstepB, voffB);
            PG8_WAIT_V(6); PG8_BAR; PG8_MMA(1, 1, At, B1); PG8_BAR;
        }
        if constexpr (!Epi::AFTER_DRAIN) E(acc, cur, wr, wc, fr, fq);
        if (!has_next) break;
#pragma unroll
        for (int a = 0; a < 2; ++a)
#pragma unroll
            for (int b = 0; b < 2; ++b)
#pragma unroll
                for (int m = 0; m < 4; ++m)
#pragma unroll
                    for (int n = 0; n < 2; ++n) acc[a][b][m][n] = (f32x4){0.f, 0.f, 0.f, 0.f};
        cur = nxt; cA = nA; cB = nB; ++ui;
    }
    PG8_WAIT_V(0);
    if (wr == 0) PG8_BAR;
    PG8_BAR;
    if constexpr (Epi::AFTER_DRAIN) E(acc, cur, wr, wc, fr, fq);
#undef PG8_SA
#undef PG8_SB
#undef PG8_STAGE
#undef PG8_LDA
#undef PG8_LDB
#undef PG8_MMA
#undef PG8_WAIT_V
#undef PG8_WAIT_L
#undef PG8_BAR
#undef PG8_SCHED
}
}

#define EPI_ARGS const f32x4 (&acc)[2][2][4][2], const pg8::Unit& u, int wr, int wc, int fr, int fq
struct EpiEvenIn {
    static constexpr bool AFTER_DRAIN = false;
    bf16_t* Pb; float* Pg; float* Pl; const float* lb;
    __device__ __forceinline__ void operator()(EPI_ARGS) const {
        const int row0 = u.pm * 256 + wr * 64 + fr, pn = u.pn;
        if (pn >= 4 && pn < 12) {
#pragma unroll
            for (int bj = 0; bj < 2; ++bj)
#pragma unroll
                for (int n = 0; n < 2; ++n) {
                    const int gc = pn * 256 + bj * 128 + wc * 32 + n * 16 + 4 * fq - 1024;
                    const f32x4 l4 = *(const f32x4*)(lb + (gc & 1023));
#pragma unroll
                    for (int ai = 0; ai < 2; ++ai)
#pragma unroll
                        for (int m = 0; m < 4; ++m) {
                            const f32x4 v = acc[ai][bj][m][n]; f32x4 o;
#pragma unroll
                            for (int e = 0; e < 4; ++e) o[e] = __logf(l4[e] + (1.f - l4[e]) * sigm(v[e]));
                            *(f32x4*)(Pg + (size_t)(row0 + ai * 128 + m * 16) * 2048 + gc) = o;
                        }
                }
        } else if (pn == 32) {
            if (wc == 0) {
#pragma unroll
                for (int n = 0; n < 2; ++n)
#pragma unroll
                    for (int ai = 0; ai < 2; ++ai)
#pragma unroll
                        for (int m = 0; m < 4; ++m) *(f32x4*)(Pl + (size_t)(row0 + ai * 128 + m * 16) * 32 + n * 16 + 4 * fq) = acc[ai][0][m][n];
            }
        } else {
            const float sc = (pn < 4 || pn == 20 || pn == 21) ? 0.08838834764831845f : 1.f;
#pragma unroll
            for (int bj = 0; bj < 2; ++bj)
#pragma unroll
                for (int n = 0; n < 2; ++n) {
                    const int c = pn * 256 + bj * 128 + wc * 32 + n * 16 + 4 * fq;
#pragma unroll
                    for (int ai = 0; ai < 2; ++ai)
#pragma unroll
                        for (int m = 0; m < 4; ++m) {
                            const f32x4 v = acc[ai][bj][m][n] * sc; u32x2 w; w.x = cvt_pk_bf16(v[0], v[1]); w.y = cvt_pk_bf16(v[2], v[3]);
                            *(u32x2*)(Pb + (size_t)(row0 + ai * 128 + m * 16) * 8192 + c) = w;
                        }
                }
        }
    }
};
struct EpiResid {
    static constexpr bool AFTER_DRAIN = false;
    const float* r0; const float* r1; float* out; const float* gate;
    __device__ __forceinline__ void operator()(EPI_ARGS) const {
        const int row0 = u.pm * 256 + wr * 64 + fr; const int v = row_cvec(u.pm * 256);
        const float* src = (u.pm * 256 < NPR) ? r0 + (size_t)row0 * D : r1 + (size_t)(row0 - NPR) * D;
#pragma unroll
        for (int bj = 0; bj < 2; ++bj)
#pragma unroll
            for (int n = 0; n < 2; ++n) {
                const int c = u.pn * 256 + bj * 128 + wc * 32 + n * 16 + 4 * fq;
                const f32x4 gv = *(const f32x4*)(gate + v * 12288 + c);
#pragma unroll
                for (int ai = 0; ai < 2; ++ai)
#pragma unroll
                    for (int m = 0; m < 4; ++m) {
                        const size_t ro = (size_t)(ai * 128 + m * 16) * D + c;
                        const f32x4 x = *(const f32x4*)(src + ro);
                        *(f32x4*)(out + (size_t)row0 * D + ro) = x + gv * acc[ai][bj][m][n];
                    }
            }
    }
};
struct EpiResidNorm {
    static constexpr bool AFTER_DRAIN = true;
    const float* r0; const float* r1; float* xout; const float* gate; float* slots; unsigned* cnt; const float* ng; const float* sh; const float* sc; bf16_t* hout; float* yout; LAS unsigned char* lds; int store_x;
    __device__ __forceinline__ void operator()(f32x4 (&acc)[2][2][4][2], const pg8::Unit& u, int wr, int wc, int fr, int fq) const {
        const int row0 = u.pm * 256 + wr * 64 + fr; const int v = row_cvec(u.pm * 256);
        const float* src = (u.pm * 256 < NPR) ? r0 + (size_t)row0 * D : r1 + (size_t)(row0 - NPR) * D;
#pragma unroll
        for (int bj = 0; bj < 2; ++bj)
#pragma unroll
            for (int n = 0; n < 2; ++n) {
                const int c = u.pn * 256 + bj * 128 + wc * 32 + n * 16 + 4 * fq;
                const f32x4 gv = *(const f32x4*)(gate + v * 12288 + c);
#pragma unroll
                for (int ai = 0; ai < 2; ++ai)
#pragma unroll
                    for (int m = 0; m < 4; ++m) {
                        const unsigned ro = (unsigned)((ai * 128 + m * 16) * D + c);
                        const f32x4 x = *(const f32x4*)(src + ro) + gv * acc[ai][bj][m][n];
                        acc[ai][bj][m][n] = x;
                        if (store_x) *(f32x4*)(xout + (size_t)row0 * D + ro) = x;
                        if (m & 1) { asm volatile("" ::: "memory"); __builtin_amdgcn_sched_barrier(0); }
                    }
            }
        LAS float* Pt = (LAS float*)lds;
        LAS float* Rt = (LAS float*)(lds + 4096);
#pragma unroll
        for (int ai = 0; ai < 2; ++ai)
#pragma unroll
            for (int m = 0; m < 4; ++m) {
                float ssq = 0.f;
#pragma unroll
                for (int bj = 0; bj < 2; ++bj)
#pragma unroll
                    for (int n = 0; n < 2; ++n) { const f32x4 x = acc[ai][bj][m][n]; ssq += (x[0] * x[0] + x[1] * x[1]) + (x[2] * x[2] + x[3] * x[3]); }
                ssq += __shfl_xor(ssq, 16); ssq += __shfl_xor(ssq, 32);
                if (fq == 0) Pt[(ai * 128 + wr * 64 + m * 16 + fr) * 4 + wc] = ssq;
            }
        __syncthreads();
        float* myslots = slots + (size_t)(u.pm * 256) * 8;
        if (threadIdx.x < 256) {
            const f32x4 p4 = *(const LAS f32x4*)(Pt + threadIdx.x * 4);
            __hip_atomic_store(myslots + threadIdx.x * 8 + u.pn, (p4[0] + p4[1]) + (p4[2] + p4[3]), __ATOMIC_RELAXED, __HIP_MEMORY_SCOPE_AGENT);
        }
        asm volatile("s_waitcnt vmcnt(0)" ::: "memory");
        __syncthreads();
        if (threadIdx.x == 0) {
            unsigned* cw = cnt + u.pm * 64;
            (void)__hip_atomic_fetch_add(cw, 1u, __ATOMIC_RELAXED, __HIP_MEMORY_SCOPE_AGENT);
            unsigned spins = 0;
            while (__hip_atomic_load(cw, __ATOMIC_RELAXED, __HIP_MEMORY_SCOPE_AGENT) < 8u) { __builtin_amdgcn_s_sleep(2); if (++spins > (1u << 22)) break; }
        }
        __syncthreads();
        __builtin_amdgcn_fence(__ATOMIC_ACQUIRE, "agent");
        if (threadIdx.x < 256) {
            float ss = 0.f;
#pragma unroll
            for (int t = 0; t < 8; ++t) ss += __hip_atomic_load(myslots + threadIdx.x * 8 + t, __ATOMIC_RELAXED, __HIP_MEMORY_SCOPE_AGENT);
            Rt[threadIdx.x] = rsqrtf(ss * (1.f / D) + 1e-6f);
        }
        __syncthreads();
        float rinv[2][4];
#pragma unroll
        for (int ai = 0; ai < 2; ++ai)
#pragma unroll
            for (int m = 0; m < 4; ++m) rinv[ai][m] = Rt[ai * 128 + wr * 64 + m * 16 + fr];
#pragma unroll
        for (int bj = 0; bj < 2; ++bj)
#pragma unroll
            for (int n = 0; n < 2; ++n) {
                const int c = u.pn * 256 + bj * 128 + wc * 32 + n * 16 + 4 * fq;
                f32x4 g4 = *(const f32x4*)(ng + c), s4 = {0.f, 0.f, 0.f, 0.f};
                if (sh) { g4 = g4 * (*(const f32x4*)(sc + v * 12288 + c) + 1.f); s4 = *(const f32x4*)(sh + v * 12288 + c); }
#pragma unroll
                for (int ai = 0; ai < 2; ++ai)
#pragma unroll
                    for (int m = 0; m < 4; ++m) {
                        const unsigned ro = (unsigned)(row0 + ai * 128 + m * 16) * (unsigned)D + (unsigned)c;
                        const f32x4 o = acc[ai][bj][m][n] * rinv[ai][m] * g4 + s4;
                        if (yout) __builtin_nontemporal_store(o, (f32x4*)(yout + ro));
                        else { u32x2 w; w.x = cvt_pk_bf16(o[0], o[1]); w.y = cvt_pk_bf16(o[2], o[3]); *(u32x2*)(hout + ro) = w; }
                        asm volatile("" ::: "memory"); __builtin_amdgcn_sched_barrier(0);
                    }
            }
    }
};
struct EpiSwiglu {
    static constexpr bool AFTER_DRAIN = false;
    bf16_t* act;
    __device__ __forceinline__ void operator()(EPI_ARGS) const {
        const int row0 = u.pm * 256 + wr * 64 + fr;
#pragma unroll
        for (int n = 0; n < 2; ++n) {
            const int j = u.pn * 128 + wc * 32 + n * 16 + 4 * fq;
#pragma unroll
            for (int ai = 0; ai < 2; ++ai)
#pragma unroll
                for (int m = 0; m < 4; ++m) {
                    const f32x4 gt = acc[ai][0][m][n], up = acc[ai][1][m][n]; f32x4 o;
#pragma unroll
                    for (int e = 0; e < 4; ++e) o[e] = gt[e] * sigm(gt[e]) * up[e];
                    u32x2 w; w.x = cvt_pk_bf16(o[0], o[1]); w.y = cvt_pk_bf16(o[2], o[3]);
                    *(u32x2*)(act + (size_t)(row0 + ai * 128 + m * 16) * DFF + j) = w;
                }
        }
    }
};
struct EpiOddIn {
    static constexpr bool AFTER_DRAIN = false;
    bf16_t* xr; bf16_t* gg;
    __device__ __forceinline__ void operator()(EPI_ARGS) const {
        const int row0 = u.pm * 256 + wr * 64 + fr;
#pragma unroll
        for (int bj = 0; bj < 2; ++bj)
#pragma unroll
            for (int n = 0; n < 2; ++n) {
                const int c = u.pn * 256 + bj * 128 + wc * 32 + n * 16 + 4 * fq;
#pragma unroll
                for (int ai = 0; ai < 2; ++ai)
#pragma unroll
                    for (int m = 0; m < 4; ++m) {
                        const f32x4 v = acc[ai][bj][m][n]; const size_t r = (size_t)(row0 + ai * 128 + m * 16);
                        if (u.pn < 8) { u32x2 w; w.x = cvt_pk_bf16(v[0], v[1]); w.y = cvt_pk_bf16(v[2], v[3]); *(u32x2*)(xr + r * D + c) = w; }
                        else { u32x2 w; w.x = cvt_pk_bf16(gelu_tanh(v[0]), gelu_tanh(v[1])); w.y = cvt_pk_bf16(gelu_tanh(v[2]), gelu_tanh(v[3])); *(u32x2*)(gg + r * D + (c - 2048)) = w; }
                    }
            }
    }
};
struct EpiGate {
    static constexpr bool AFTER_DRAIN = false;
    const bf16_t* xcb; const float* rg_b; const float* ig_b; const float* lam; unsigned* au0; unsigned* au1;
    __device__ __forceinline__ void operator()(EPI_ARGS) const {
        const int dir = u.pn >> 4, cg = u.pn & 15;
        unsigned* au = dir ? au1 : au0;
        const unsigned rowoff = (unsigned)(u.pm * 256 + wr * 64 + fr) * (unsigned)D + (unsigned)(cg * 128 + wc * 32 + 4 * fq);
        const int chb = dir * D + cg * 128 + wc * 32 + 4 * fq;
#pragma unroll
        for (int n = 0; n < 2; ++n) {
            asm volatile("" ::: "memory"); __builtin_amdgcn_sched_barrier(0);
            const f32x4 rb = *(const f32x4*)(rg_b + chb + n * 16), ib = *(const f32x4*)(ig_b + chb + n * 16), lm = *(const f32x4*)(lam + chb + n * 16);
            f32x4 sp;
#pragma unroll
            for (int e = 0; e < 4; ++e) { const float t = __expf(-lm[e]); sp[e] = -8.f * (t < 0.03f ? t * (1.f - t * (0.5f - t * (0.33333334f - 0.25f * t))) : __logf(1.f + t)); }
#pragma unroll
            for (int ai = 0; ai < 2; ++ai)
#pragma unroll
                for (int m = 0; m < 4; ++m) {
                    const unsigned o = rowoff + (unsigned)((ai * 128 + m * 16) * D + n * 16);
                    const u32x2 xw = *(const u32x2*)(xcb + o);
                    const float x0 = __uint_as_float(xw.x << 16), x1 = __uint_as_float(xw.x & 0xffff0000u), x2v = __uint_as_float(xw.y << 16), x3 = __uint_as_float(xw.y & 0xffff0000u);
                    const f32x4 x = {x0, x1, x2v, x3};
                    const f32x4 rp = acc[ai][0][m][n] + rb, ip = acc[ai][1][m][n] + ib; unsigned pk[4];
#pragma unroll
                    for (int e = 0; e < 4; ++e) { const float la = sp[e] * sigm(rp[e]); const float a = __expf(la);
                        const float oma = 1.f - a;
                        pk[e] = cvt_pk_bf16(__builtin_amdgcn_sqrtf(oma * (1.f + a)) * sigm(ip[e]) * x[e], oma); }
                    *(u32x4*)(au + o) = (u32x4){pk[0], pk[1], pk[2], pk[3]};
                    asm volatile("" ::: "memory"); __builtin_amdgcn_sched_barrier(0);
                }
        }
    }
};

struct ConvTile { const float* src; int ldw; int nvalid; bf16_t* dst; int K; };
__device__ __forceinline__ ConvTile conv_decode(const Params& p, int t) {
    ConvTile c; int m, local;
    if (t < 528) { m = 0; local = t; } else if (t < 656) { m = 1; local = t - 528; } else if (t < 1360) { m = 2; local = t - 656; } else if (t < 2064) { m = 3; local = t - 1360; }
    else if (t < 2416) { m = 4; local = t - 2064; } else if (t < 2768) { m = 5; local = t - 2416; } else if (t < 3024) { m = 6; local = t - 2768; } else if (t < 3088) { m = 7; local = t - 3024; } else { m = 8; local = t - 3088; }
    const int K = (m == 4 || m == 5) ? DFF : (m == 7 ? 256 : D); const int kts = K / 256; const int nb = local / kts, kt = local % kts; const int k0 = kt * 256;
    c.K = K; c.nvalid = 128;
    unsigned char* ws = p.ws;
    switch (m) {
    case 0: { const int col0 = nb * 128; c.src = INP(14) + (size_t)k0 * NEVEN + col0; c.ldw = NEVEN; c.nvalid = NEVEN - col0 < 128 ? (NEVEN - col0 < 0 ? 0 : NEVEN - col0) : 128; c.dst = (bf16_t*)(ws + WS_WT_EVEN_IN) + (size_t)nb * 128 * K + k0; } break;
    case 1: c.src = INP(19) + (size_t)k0 * D + nb * 128; c.ldw = D; c.dst = (bf16_t*)(ws + WS_WT_EVEN_OUT) + (size_t)nb * 128 * K + k0; break;
    case 2: case 3: { const int l = m - 2, pn = nb >> 1, half = nb & 1; c.src = INP(11) + (size_t)l * D * 2 * DFF + (size_t)k0 * 2 * DFF + half * DFF + pn * 128; c.ldw = 2 * DFF;
        c.dst = (bf16_t*)(ws + (l ? WS_WT_FFN_IN1 : WS_WT_FFN_IN0)) + (size_t)nb * 128 * K + k0; } break;
    case 4: case 5: { const int l = m - 4; c.src = INP(12) + (size_t)l * DFF * D + (size_t)k0 * D + nb * 128; c.ldw = D; c.dst = (bf16_t*)(ws + (l ? WS_WT_FFN_OUT1 : WS_WT_FFN_OUT0)) + (size_t)nb * 128 * K + k0; } break;
    case 6: c.src = INP(20) + (size_t)k0 * 4096 + nb * 128; c.ldw = 4096; c.dst = (bf16_t*)(ws + WS_WT_ODD_IN) + (size_t)nb * 128 * K + k0; break;
    case 7: { const int pn = nb >> 1, half = nb & 1, dir = pn >> 4, cg = pn & 15, ch0 = cg * 128, blk = ch0 >> 8, d0 = ch0 & 255;
        c.src = (half ? INP(25) : INP(23)) + (size_t)(dir * 8 + blk) * 256 * 256 + (size_t)k0 * 256 + d0; c.ldw = 256; c.dst = (bf16_t*)(ws + WS_WT_GATE) + (size_t)nb * 128 * K + k0; } break;
    default: c.src = INP(28) + (size_t)k0 * D + nb * 128; c.ldw = D; c.dst = (bf16_t*)(ws + WS_WT_ODD_OUT) + (size_t)nb * 128 * K + k0; break;
    }
    return c;
}
constexpr int NCONV_TILES = 3216;

constexpr int NCONV_L0 = 1360 + 352, NCONV_L1 = NCONV_TILES - NCONV_L0;
template <int LIST>
__device__ __forceinline__ int conv_map(int v) { return LIST == 0 ? (v < 1360 ? v : v + 704) : (v < 704 ? 1360 + v : 2416 + (v - 704)); }
template <int LIST>
__device__ __forceinline__ void convert_tiles(const Params& p, int wg, int nwg) {
    const int tid = threadIdx.x, n = tid & 127, kq = tid >> 7; constexpr int NT = LIST == 0 ? NCONV_L0 : NCONV_L1;
    const int per = (NT + nwg - 1) / nwg, vend = (wg + 1) * per < NT ? (wg + 1) * per : NT;
    for (int v = wg * per; v < vend; ++v) {
        const ConvTile c0 = conv_decode(p, conv_map<LIST>(v));
        float v0[64];
        const float* s0 = c0.src + (size_t)(kq * 64) * c0.ldw + n;
        const bool ok0 = n < c0.nvalid;
#pragma unroll
        for (int j = 0; j < 64; ++j) v0[j] = ok0 ? __builtin_nontemporal_load(s0 + (size_t)j * c0.ldw) : 0.f;
        bf16_t* dp = c0.dst + (size_t)n * c0.K + kq * 64;
#pragma unroll
        for (int q = 0; q < 8; ++q) *(u32x4*)(dp + q * 8) = (u32x4){cvt_pk_bf16(v0[8 * q], v0[8 * q + 1]), cvt_pk_bf16(v0[8 * q + 2], v0[8 * q + 3]), cvt_pk_bf16(v0[8 * q + 4], v0[8 * q + 5]), cvt_pk_bf16(v0[8 * q + 6], v0[8 * q + 7])};
    }
}

__device__ __forceinline__ void modulation_tasks(const Params& p, LAS unsigned char* lds, int l, int wg, int nwg) {
    const int tid = threadIdx.x;
    LAS float* lf = (LAS float*)lds;
    float* mod = (float*)(p.ws + WS_MOD);
    LAS float* sv = lf;
    LAS float* red = lf + 6144;
    const float* cctx = INP(6); const float* cvec = INP(5); const float* wmod = INP(9); const float* bmod = INP(10);
    for (int cb = wg; cb < 96; cb += nwg) {
        for (int i = tid; i < 6144; i += NTHREADS) { const int v = i >> 11, k = i & 2047; const float c = (v == 0) ? cctx[k] : cvec[(v - 1) * D + k]; sv[i] = c * sigm(c); }
        __syncthreads();
        const int j4 = tid & 31, kg = tid >> 5;
        const float* w = wmod + ((size_t)l * D + kg * 128) * 12288 + cb * 128 + j4 * 4;
        f32x4 a0 = {0.f, 0.f, 0.f, 0.f}, a1 = a0, a2 = a0;
#pragma unroll 8
        for (int k = 0; k < 128; ++k) { const f32x4 wv = __builtin_nontemporal_load((const f32x4*)(w + (size_t)k * 12288)); const int kk = kg * 128 + k; a0 += wv * sv[kk]; a1 += wv * sv[2048 + kk]; a2 += wv * sv[4096 + kk]; }
        LAS float* rr = red + (kg * 32 + j4) * 12;
#pragma unroll
        for (int e = 0; e < 4; ++e) { rr[e] = a0[e]; rr[4 + e] = a1[e]; rr[8 + e] = a2[e]; }
        __syncthreads();
        if (tid < 384) {
            const int q = tid % 12, jj = tid / 12, v = q >> 2, e = q & 3, col = cb * 128 + jj * 4 + e;
            float s2 = bmod[l * 12288 + col];
#pragma unroll
            for (int g2 = 0; g2 < 16; ++g2) s2 += red[(g2 * 32 + jj) * 12 + q];
            mod[(l * 3 + v) * 12288 + col] = s2;
        }
        __syncthreads();
    }
}

__device__ __forceinline__ void phase0(const Params& p, LAS unsigned char* lds) {
    const int tid = threadIdx.x, G = gridDim.x, b = blockIdx.x;
    LAS float* lf = (LAS float*)lds;
    if (b == G - 1) {
        const float* lp = INP(13); float* lb = (float*)(p.ws + WS_LB);
        for (int d = tid; d < 1024; d += NTHREADS) { const float a = lp[d], b1 = lp[1024 + d], c = lp[2048 + d]; const float mx = fmaxf(a, fmaxf(b1, c)); const float e0 = expf(a - mx), e1 = expf(b1 - mx), e2 = expf(c - mx); lb[d] = e0 / (e0 + e1 + e2); }
    }
    modulation_tasks(p, lds, 0, b, G);
    convert_tiles<0>(p, b, G);
}

__device__ __forceinline__ void phase_normmod(const float* x0, const float* x1, const float* g, const float* sh, const float* sc, bf16_t* hout) {
    const int lane = threadIdx.x & 63; const int gw = blockIdx.x * 8 + (threadIdx.x >> 6), nw = gridDim.x * 8;
    for (int rowa = gw; rowa < MTOK; rowa += 2 * nw) {
        const int rowb = rowa + nw; const bool hb = rowb < MTOK; const int rb = hb ? rowb : rowa;
        const float* xa = rowa < NPR ? x0 + (size_t)rowa * D : x1 + (size_t)(rowa - NPR) * D; const float* xb = rb < NPR ? x0 + (size_t)rb * D : x1 + (size_t)(rb - NPR) * D;
        const int va = row_cvec(rowa), vb = row_cvec(rb);
        f32x4 xv[8], yv[8]; float sa = 0.f, sb = 0.f;
#pragma unroll
        for (int i = 0; i < 8; ++i) { xv[i] = *(const f32x4*)(xa + (i * 64 + lane) * 4); yv[i] = *(const f32x4*)(xb + (i * 64 + lane) * 4); }
#pragma unroll
        for (int i = 0; i < 8; ++i) { sa += xv[i][0] * xv[i][0] + xv[i][1] * xv[i][1] + xv[i][2] * xv[i][2] + xv[i][3] * xv[i][3]; sb += yv[i][0] * yv[i][0] + yv[i][1] * yv[i][1] + yv[i][2] * yv[i][2] + yv[i][3] * yv[i][3]; }
        sa = wave_sum(sa); sb = wave_sum(sb); const float ra = rsqrtf(sa * (1.f / D) + 1e-6f), rbv = rsqrtf(sb * (1.f / D) + 1e-6f);
#pragma unroll
        for (int i = 0; i < 8; ++i) {
            const int c = (i * 64 + lane) * 4; const f32x4 gv = *(const f32x4*)(g + c);
            { const f32x4 sv = *(const f32x4*)(sc + va * 12288 + c), hv = *(const f32x4*)(sh + va * 12288 + c);
              const f32x4 o = xv[i] * ra * gv * (sv + 1.f) + hv; u32x2 w; w.x = cvt_pk_bf16(o[0], o[1]); w.y = cvt_pk_bf16(o[2], o[3]); *(u32x2*)(hout + (size_t)rowa * D + c) = w; }
            if (hb) { const f32x4 sv = *(const f32x4*)(sc + vb * 12288 + c), hv = *(const f32x4*)(sh + vb * 12288 + c);
              const f32x4 o = yv[i] * rbv * gv * (sv + 1.f) + hv; u32x2 w; w.x = cvt_pk_bf16(o[0], o[1]); w.y = cvt_pk_bf16(o[2], o[3]); *(u32x2*)(hout + (size_t)rowb * D + c) = w; }
        }
    }
}
__device__ __forceinline__ void phase_finalnorm(const float* x, const float* g, float* out) {
    const int lane = threadIdx.x & 63; const int gw = blockIdx.x * 8 + (threadIdx.x >> 6), nw = gridDim.x * 8;
    for (int rowa = gw; rowa < MTOK; rowa += 2 * nw) {
        const int rowb = rowa + nw; const bool hb = rowb < MTOK; const int rb = hb ? rowb : rowa;
        const float* xa = x + (size_t)rowa * D; const float* xb = x + (size_t)rb * D; f32x4 xv[8], yv[8]; float sa = 0.f, sb = 0.f;
#pragma unroll
        for (int i = 0; i < 8; ++i) { xv[i] = *(const f32x4*)(xa + (i * 64 + lane) * 4); yv[i] = *(const f32x4*)(xb + (i * 64 + lane) * 4); }
#pragma unroll
        for (int i = 0; i < 8; ++i) { sa += xv[i][0] * xv[i][0] + xv[i][1] * xv[i][1] + xv[i][2] * xv[i][2] + xv[i][3] * xv[i][3]; sb += yv[i][0] * yv[i][0] + yv[i][1] * yv[i][1] + yv[i][2] * yv[i][2] + yv[i][3] * yv[i][3]; }
        sa = wave_sum(sa); sb = wave_sum(sb); const float ra = rsqrtf(sa * (1.f / D) + 1e-6f), rbv = rsqrtf(sb * (1.f / D) + 1e-6f);
#pragma unroll
        for (int i = 0; i < 8; ++i) { const int c = (i * 64 + lane) * 4; const f32x4 gv = *(const f32x4*)(g + c);
            *(f32x4*)(out + (size_t)rowa * D + c) = xv[i] * ra * gv; if (hb) *(f32x4*)(out + (size_t)rowb * D + c) = yv[i] * rbv * gv; }
    }
}

constexpr size_t IMG_UNIT = 25088, IMG_VUNIT = 8192;
constexpr size_t WS_IMG_A = WS_HBUF, WS_IMG_B = WS_IMG_A + 4096 * IMG_UNIT, WS_IMG_V = WS_IMG_B + 2048 * IMG_UNIT, WS_IMG_END = WS_IMG_V + 4096 * IMG_VUNIT;
static_assert(WS_IMG_END <= WS_R, "operand images must fit in hbuf + xbuf + act");
constexpr int TOT_OFF = 0;
constexpr int BL_OFF = 2048;

__device__ __forceinline__ void phase_gateprep(const Params& p, LAS unsigned char* lds) {
    const int tid = threadIdx.x, hl = tid >> 7, d = tid & 127, G = gridDim.x;
    const bf16_t* Pb = (const bf16_t*)(p.ws + WS_PB); const float* Pg = (const float*)(p.ws + WS_PG); const float* Pl = (const float*)(p.ws + WS_PL);
    const float* wal = INP(15); const float* bal = INP(16);
    LAS float* BLs = (LAS float*)lds;
    for (int u = blockIdx.x; u < 1536; u += G) {
        const int kind = u >= 1024; const int uu = kind ? u - 1024 : u;
        const int hg = kind ? 0 : (uu & 1), dir = kind ? (uu & 1) : ((uu >> 1) & 1), sc = kind ? (uu >> 1) : (uu >> 2);
        const int head = hg * 4 + hl;
        const int qcol = kind ? 5120 + head * 128 : head * 128, kcol = 5632 + head * 128, gcol = dir * 1024 + head * 128;
        const size_t r0 = (size_t)sc * 32;
        float g[32]; unsigned qv[32], kv[32];
        if (kind) {
#pragma unroll
            for (int i = 0; i < 32; ++i) { qv[i] = Pb[(r0 + i) * 8192 + qcol + d]; kv[i] = Pb[(r0 + i) * 8192 + kcol + d]; }
            if (tid < 128) *(LAS f32x4*)(BLs + tid * 4) = *(const f32x4*)(Pl + (r0 + (tid >> 2)) * 32 + dir * 16 + (tid & 3) * 4);
            float wa[16];
#pragma unroll
            for (int r = 0; r < 16; ++r) wa[r] = wal[(dir * 16 + r) * 512 + head * 128 + d];
            const float ba = bal[dir * 512 + head * 128 + d];
            __syncthreads();
#pragma unroll
            for (int i = 0; i < 32; ++i) { float z = ba;
#pragma unroll
                for (int r4 = 0; r4 < 4; ++r4) { const f32x4 bv = *(const LAS f32x4*)(BLs + i * 16 + r4 * 4); z += bv[0] * wa[r4 * 4] + bv[1] * wa[r4 * 4 + 1] + bv[2] * wa[r4 * 4 + 2] + bv[3] * wa[r4 * 4 + 3]; }
                g[i] = (fminf(z, 0.f) - __logf(1.f + __expf(-fabsf(z)))) * 0.0625f; }
        } else {
#pragma unroll
            for (int i = 0; i < 32; ++i) { g[i] = Pg[(r0 + i) * 2048 + gcol + d]; qv[i] = Pb[(r0 + i) * 8192 + qcol + d]; }
        }
        unsigned char* img = p.ws + (kind ? WS_IMG_B : WS_IMG_A) + (size_t)(kind ? ((sc * 2 + dir) * 4 + head) : ((sc * 2 + dir) * 8 + head)) * IMG_UNIT;
        bf16_t* Qg = (bf16_t*)img; bf16_t* Kg = (bf16_t*)(img + 8192);
        float tot = 0.f;
#pragma unroll
        for (int i = 0; i < 32; ++i) tot += g[i];
        float run = 0.f; unsigned ktp[16] = {};
#pragma unroll
        for (int e = 0; e < 32; ++e) {
            const int i = dir ? 31 - e : e;
            run += g[i];
            const float kvf = kind ? __uint_as_float(kv[i] << 16) : 1.f - __expf(g[i]);
            const float qd = __uint_as_float(qv[i] << 16) * __expf(run), ki = kvf * __expf(-run), kt = kvf * __expf(tot - run);
            Qg[i * 128 + d] = (bf16_t)(cvt_pk_bf16(qd, 0.f) & 0xffffu); Kg[i * 128 + d] = (bf16_t)(cvt_pk_bf16(ki, 0.f) & 0xffffu);
            const unsigned kb = cvt_pk_bf16(kt, 0.f) & 0xffffu;
            if (i & 1) ktp[i >> 1] = (ktp[i >> 1] & 0xffffu) | (kb << 16); else ktp[i >> 1] = (ktp[i >> 1] & 0xffff0000u) | kb;
        }
#pragma unroll
        for (int q4 = 0; q4 < 4; ++q4) *(u32x4*)(img + 16384 + d * 64 + q4 * 16) = (u32x4){ktp[4 * q4], ktp[4 * q4 + 1], ktp[4 * q4 + 2], ktp[4 * q4 + 3]};
        *(float*)(img + 24576 + d * 4) = __expf(tot);
        if (dir == 0) {
            const int ns = kind ? 2 : 1;
            for (int sl = 0; sl < ns; ++sl) {
                const int vcol = kind ? 6144 + head * 256 + sl * 128 : 3072 + head * 128;
                unsigned vv[32];
#pragma unroll
                for (int i = 0; i < 32; ++i) vv[i] = Pb[(r0 + i) * 8192 + vcol + d];
                unsigned char* vimg = p.ws + WS_IMG_V + (size_t)(kind ? 2048 + (sc * 4 + head) * 2 + sl : sc * 8 + head) * IMG_VUNIT;
#pragma unroll
                for (int q4 = 0; q4 < 4; ++q4) *(u32x4*)(vimg + d * 64 + q4 * 16) = (u32x4){vv[8 * q4] | (vv[8 * q4 + 1] << 16), vv[8 * q4 + 2] | (vv[8 * q4 + 3] << 16), vv[8 * q4 + 4] | (vv[8 * q4 + 5] << 16), vv[8 * q4 + 6] | (vv[8 * q4 + 7] << 16)};
            }
        }
        if (kind) __syncthreads();
    }
}

constexpr int MB_QS = 0, MB_KS = 8704, MB_KT = 17408, MB_VT = 27648, MB_EB = 37888, MB_SIZE = 38400;
template <int KIND  >
__device__ __forceinline__ void mixer_item(const Params& p, LAS unsigned char* lds, int seq, int head, int dir, int slice) {
    const int tid = threadIdx.x, lane = tid & 63, w = tid >> 6, fr = lane & 15, fq = lane >> 4;
    bf16_t* Ob = (bf16_t*)(p.ws + (dir ? WS_OB : WS_OF));
    const int T = seq < 16 ? 256 : 2048, row0 = seq < 16 ? seq * 256 : NPR + (seq - 16) * 2048, nch = T / 32, sc0 = row0 / 32;
    const int ocol = KIND == 0 ? head * 128 : 1024 + head * 256 + slice * 128;
#define SD(dt, jj) (32 * ((dt) >> 1) + 8 * fq + 4 * ((dt) & 1) + (jj))
    f32x4 S[8];
    if (seq < 16) {
#pragma unroll
        for (int dt = 0; dt < 8; ++dt) S[dt] = (f32x4){0.f, 0.f, 0.f, 0.f};
    } else {
        const int bs = seq - 16;
        const float* s0 = KIND == 0 ? INP(2) + (size_t)((bs * 2 + dir) * 8 + head) * 128 * 128 : INP(3) + (size_t)((bs * 2 + dir) * 4 + head) * 128 * 256 + slice * 128;
        const int ld = KIND == 0 ? 128 : 256;
#pragma unroll
        for (int dt = 0; dt < 8; ++dt)
#pragma unroll
            for (int jj = 0; jj < 4; ++jj) S[dt][jj] = s0[(size_t)SD(dt, jj) * ld + 16 * w + fr];
    }
    const int lq = (tid >> 4) * 272 + (tid & 15) * 16;
    const int lk = (tid >> 2) * 80 + (tid & 3) * 16;
    const unsigned char* imgb = p.ws + (KIND ? WS_IMG_B : WS_IMG_A); const unsigned char* vimgb = p.ws + WS_IMG_V;
    u32x4 rq, rk, rt, rv, re;
#define MIX_SC(c) (sc0 + (dir ? nch - 1 - (c) : (c)))
#define MIX_LOAD(c) do { const int sc_ = MIX_SC(c); \
        const unsigned char* im_ = imgb + (size_t)(KIND ? ((sc_ * 2 + dir) * 4 + head) : ((sc_ * 2 + dir) * 8 + head)) * IMG_UNIT + tid * 16; \
        const unsigned char* vm_ = vimgb + (size_t)(KIND ? 2048 + (sc_ * 4 + head) * 2 + slice : sc_ * 8 + head) * IMG_VUNIT + tid * 16; \
        rq = __builtin_nontemporal_load((const u32x4*)im_); rk = __builtin_nontemporal_load((const u32x4*)(im_ + 8192)); rt = __builtin_nontemporal_load((const u32x4*)(im_ + 16384)); rv = __builtin_nontemporal_load((const u32x4*)vm_); \
        if (tid < 32) re = __builtin_nontemporal_load((const u32x4*)(im_ + 24576)); } while (0)
#define MIX_LAND() do { asm volatile("" : "+v"(rq)); asm volatile("" : "+v"(rk)); asm volatile("" : "+v"(rt)); asm volatile("" : "+v"(rv)); if (tid < 32) asm volatile("" : "+v"(re)); } while (0)
    MIX_LOAD(0); MIX_LAND();
    for (int c = 0; c < nch; ++c) {
      {
        LAS unsigned char* mb = lds + (c & 1) * MB_SIZE;
        *(LAS u32x4*)(mb + MB_QS + lq) = rq; *(LAS u32x4*)(mb + MB_KS + lq) = rk; *(LAS u32x4*)(mb + MB_KT + lk) = rt; *(LAS u32x4*)(mb + MB_VT + lk) = rv;
        if (tid < 32) *(LAS u32x4*)(mb + MB_EB + tid * 16) = re;
        __syncthreads();
        if (c + 1 < nch) MIX_LOAD(c + 1);
        __builtin_amdgcn_sched_barrier(0);
        LAS bf16_t* Qs = (LAS bf16_t*)(mb + MB_QS); LAS bf16_t* Ks = (LAS bf16_t*)(mb + MB_KS); LAS bf16_t* KTs = (LAS bf16_t*)(mb + MB_KT); LAS bf16_t* VTs = (LAS bf16_t*)(mb + MB_VT);
        LAS float* EBs = (LAS float*)(mb + MB_EB);
        f32x4 at00 = {0.f, 0.f, 0.f, 0.f}, atx = at00, at11 = at00;
        bf16x8 qf[2][4];
#pragma unroll
        for (int k4 = 0; k4 < 4; ++k4) {
            const bf16x8 k0 = *(const LAS bf16x8*)(Ks + fr * 136 + k4 * 32 + fq * 8), k1 = *(const LAS bf16x8*)(Ks + (16 + fr) * 136 + k4 * 32 + fq * 8);
            qf[0][k4] = *(const LAS bf16x8*)(Qs + fr * 136 + k4 * 32 + fq * 8); qf[1][k4] = *(const LAS bf16x8*)(Qs + (16 + fr) * 136 + k4 * 32 + fq * 8);
            at00 = __builtin_amdgcn_mfma_f32_16x16x32_bf16(k0, qf[0][k4], at00, 0, 0, 0);
            atx = __builtin_amdgcn_mfma_f32_16x16x32_bf16(dir ? k1 : k0, dir ? qf[0][k4] : qf[1][k4], atx, 0, 0, 0);
            at11 = __builtin_amdgcn_mfma_f32_16x16x32_bf16(k1, qf[1][k4], at11, 0, 0, 0);
        }
#pragma unroll
        for (int jj = 0; jj < 4; ++jj) { const bool keep = dir ? ((4 * fq + jj) >= fr) : ((4 * fq + jj) <= fr); at00[jj] = keep ? at00[jj] : 0.f; at11[jj] = keep ? at11[jj] : 0.f; }
        const unsigned x01 = cvt_pk_bf16(atx[0], atx[1]), x23 = cvt_pk_bf16(atx[2], atx[3]);
        u32x4 pa0, pa1;
        pa0.x = cvt_pk_bf16(at00[0], at00[1]); pa0.y = cvt_pk_bf16(at00[2], at00[3]); pa0.z = dir ? x01 : 0u; pa0.w = dir ? x23 : 0u;
        pa1.x = dir ? 0u : x01; pa1.y = dir ? 0u : x23; pa1.z = cvt_pk_bf16(at11[0], at11[1]); pa1.w = cvt_pk_bf16(at11[2], at11[3]);
        u32x4 sb[4];
#pragma unroll
        for (int k4 = 0; k4 < 4; ++k4) { sb[k4].x = cvt_pk_bf16(S[2 * k4][0], S[2 * k4][1]); sb[k4].y = cvt_pk_bf16(S[2 * k4][2], S[2 * k4][3]); sb[k4].z = cvt_pk_bf16(S[2 * k4 + 1][0], S[2 * k4 + 1][1]); sb[k4].w = cvt_pk_bf16(S[2 * k4 + 1][2], S[2 * k4 + 1][3]); }
        u32x4 vf; { const u32x2 lo = *(const LAS u32x2*)(VTs + (16 * w + fr) * 40 + 4 * fq), hi = *(const LAS u32x2*)(VTs + (16 * w + fr) * 40 + 16 + 4 * fq); vf = (u32x4){lo.x, lo.y, hi.x, hi.y}; }
        const size_t orow = (size_t)MIX_SC(c) * 32;
#pragma unroll
        for (int it = 0; it < 2; ++it) {
            f32x4 o = {0.f, 0.f, 0.f, 0.f};
#pragma unroll
            for (int k4 = 0; k4 < 4; ++k4) o = __builtin_amdgcn_mfma_f32_16x16x32_bf16(__builtin_bit_cast(bf16x8, sb[k4]), qf[it][k4], o, 0, 0, 0);
            o = __builtin_amdgcn_mfma_f32_16x16x32_bf16(__builtin_bit_cast(bf16x8, vf), __builtin_bit_cast(bf16x8, it ? pa1 : pa0), o, 0, 0, 0);
            u32x2 ow; ow.x = cvt_pk_bf16(o[0], o[1]); ow.y = cvt_pk_bf16(o[2], o[3]);
            *(u32x2*)(Ob + (orow + 16 * it + fr) * D + ocol + 16 * w + 4 * fq) = ow;
        }
        const bf16x8 vb = *(const LAS bf16x8*)(VTs + (16 * w + fr) * 40 + fq * 8);
#pragma unroll
        for (int dt = 0; dt < 8; ++dt) {
            const f32x4 eb = *(const LAS f32x4*)(EBs + 32 * (dt >> 1) + 8 * fq + 4 * (dt & 1));
            const bf16x8 ka = *(const LAS bf16x8*)(KTs + (32 * (dt >> 1) + 8 * (fr >> 2) + 4 * (dt & 1) + (fr & 3)) * 40 + fq * 8);
            S[dt] = __builtin_amdgcn_mfma_f32_16x16x32_bf16(ka, vb, S[dt] * eb, 0, 0, 0);
        }
        __builtin_amdgcn_sched_barrier(0);
        MIX_LAND();
      }
    }
    __syncthreads();
#undef MIX_LAND
#undef MIX_LOAD
#undef MIX_SC
    if (seq < 16) {
        float* so = KIND == 0 ? p.out + OUT_H + (size_t)((seq * 2 + dir) * 8 + head) * 128 * 128 : p.out + OUT_G + (size_t)((seq * 2 + dir) * 4 + head) * 128 * 256 + slice * 128;
        const int ld = KIND == 0 ? 128 : 256;
#pragma unroll
        for (int dt = 0; dt < 8; ++dt)
#pragma unroll
            for (int jj = 0; jj < 4; ++jj) so[(size_t)SD(dt, jj) * ld + 16 * w + fr] = S[dt][jj];
    }
}
#undef SD
#ifndef MIXK
#define MIXK 2
#endif
__device__ __forceinline__ void phase_mixer(const Params& p, LAS unsigned char* lds) {
    const int G = gridDim.x, b = blockIdx.x;
    int it = b;
    const int step = (G >= 128) ? (b < 64 ? 100000 : G - 64) : G;
    for (; it < 576; it += step) {
        const int is_long = it < 64, idx = is_long ? it : it - 64;
        const int per = is_long ? 32 : 256; const int kind = idx / per, r = idx % per; const int seq = (is_long ? 16 : 0) + r / 16, rem = r % 16;
        if (kind == 0) { if (MIXK != 1) mixer_item<0>(p, lds, seq, rem >> 1, rem & 1, 0); }
        else { if (MIXK != 0) mixer_item<1>(p, lds, seq, rem >> 2, (rem >> 1) & 1, rem & 1); }
    }
    if (G >= 128) { if (b >= 64) convert_tiles<1>(p, b - 64, G - 64); }
    else convert_tiles<1>(p, b, G);
}

__device__ __forceinline__ void phase_combine(const Params& p) {
    const int lane = threadIdx.x & 63; const int gw = blockIdx.x * 8 + (threadIdx.x >> 6), nw = gridDim.x * 8;
    const float* gainA = INP(17); const float* gainB = INP(18);
    const bf16_t* Of = (const bf16_t*)(p.ws + WS_OF); const bf16_t* Obw = (const bf16_t*)(p.ws + WS_OB); const bf16_t* Pb = (const bf16_t*)(p.ws + WS_PB); bf16_t* mg = (bf16_t*)(p.ws + WS_HBUF);
    for (int row = gw; row < MTOK; row += nw) {
#pragma unroll
        for (int i = 0; i < 8; ++i) {
            const int c = i * 256 + lane * 4;
            const u32x2 of2 = *(const u32x2*)(Of + (size_t)row * D + c), ob2 = *(const u32x2*)(Obw + (size_t)row * D + c);
            const f32x4 o = {__uint_as_float(of2.x << 16) + __uint_as_float(ob2.x << 16), __uint_as_float(of2.x & 0xffff0000u) + __uint_as_float(ob2.x & 0xffff0000u),
                             __uint_as_float(of2.y << 16) + __uint_as_float(ob2.y << 16), __uint_as_float(of2.y & 0xffff0000u) + __uint_as_float(ob2.y & 0xffff0000u)};
            float ss = o[0] * o[0] + o[1] * o[1] + o[2] * o[2] + o[3] * o[3];
            ss += __shfl_xor(ss, 1); ss += __shfl_xor(ss, 2); ss += __shfl_xor(ss, 4); ss += __shfl_xor(ss, 8); ss += __shfl_xor(ss, 16);
            float rinv; f32x4 gn; int gcol;
            if (i < 4) { rinv = rsqrtf(ss * (1.f / 128.f) + 1e-6f); gn = *(const f32x4*)(gainA + (c & 127)); gcol = 4096 + c; }
            else { ss += __shfl_xor(ss, 32); rinv = rsqrtf(ss * (1.f / 256.f) + 1e-6f); gn = *(const f32x4*)(gainB + (c & 255)); gcol = 7168 + (c - 1024); }
            const u32x2 gw2 = *(const u32x2*)(Pb + (size_t)row * 8192 + gcol);
            const float g0 = __uint_as_float(gw2.x << 16), g1 = __uint_as_float(gw2.x & 0xffff0000u), g2 = __uint_as_float(gw2.y << 16), g3 = __uint_as_float(gw2.y & 0xffff0000u);
            const f32x4 r = o * rinv * gn; u32x2 wv;
            wv.x = cvt_pk_bf16(r[0] * g0 * sigm(g0), r[1] * g1 * sigm(g1)); wv.y = cvt_pk_bf16(r[2] * g2 * sigm(g2), r[3] * g3 * sigm(g3));
            *(u32x2*)(mg + (size_t)row * D + c) = wv;
        }
    }
}

__device__ __forceinline__ void phase_conv(const Params& p) {
    const bf16_t* xr = (const bf16_t*)(p.ws + WS_XR); bf16_t* xcb = (bf16_t*)(p.ws + WS_XCB);
    const float* cw = INP(21); const float* cb = INP(22);
    const int nthr = gridDim.x * NTHREADS;
    for (int idx = blockIdx.x * NTHREADS + threadIdx.x; idx < (MTOK / 4) * 256; idx += nthr) {
        const int r0 = (idx >> 8) * 4, c = (idx & 255) * 8; const int L = r0 < NPR ? 256 : 64, pos = r0 & (L - 1);
        u32x4 xin[7];
#pragma unroll
        for (int t = 0; t < 7; ++t) { const int q = pos + t - 2; xin[t] = (q >= 0 && q < L) ? *(const u32x4*)(xr + (size_t)(r0 + t - 2) * D + c) : (u32x4){0u, 0u, 0u, 0u}; }
        f32x4 wlo[4], whi[4];
#pragma unroll
        for (int j = 0; j < 4; ++j) { wlo[j] = *(const f32x4*)(cw + j * D + c); whi[j] = *(const f32x4*)(cw + j * D + c + 4); }
        const f32x4 blo = *(const f32x4*)(cb + c), bhi = *(const f32x4*)(cb + c + 4);
#pragma unroll
        for (int o = 0; o < 4; ++o) {
            f32x4 alo = blo, ahi = bhi;
#pragma unroll
            for (int j = 0; j < 4; ++j) {
                const u32x4 xw = xin[o + j];
                const f32x4 xl = {__uint_as_float(xw.x << 16), __uint_as_float(xw.x & 0xffff0000u), __uint_as_float(xw.y << 16), __uint_as_float(xw.y & 0xffff0000u)};
                const f32x4 xh = {__uint_as_float(xw.z << 16), __uint_as_float(xw.z & 0xffff0000u), __uint_as_float(xw.w << 16), __uint_as_float(xw.w & 0xffff0000u)};
                alo += xl * wlo[j]; ahi += xh * whi[j];
            }
            *(u32x4*)(xcb + (size_t)(r0 + o) * D + c) = (u32x4){cvt_pk_bf16(alo[0], alo[1]), cvt_pk_bf16(alo[2], alo[3]), cvt_pk_bf16(ahi[0], ahi[1]), cvt_pk_bf16(ahi[2], ahi[3])};
        }
    }
}

__device__ __forceinline__ void scan_item(const Params& p, LAS unsigned char* lds, int seq, int cbk) {
    constexpr int SB = 16;
    const int tid = threadIdx.x, ch = cbk * 32 + (tid & 31), seg = tid >> 5;
    const int T = seq < 16 ? 256 : 2048, row0 = seq < 16 ? seq * 256 : NPR + (seq - 16) * 2048, sl = T / 16;
    const unsigned* const AU0 = (const unsigned*)(p.ws + WS_XR); const unsigned* const AU1 = (const unsigned*)(p.ws + WS_UF);
    bf16_t* YF = (bf16_t*)(p.ws + WS_ACT); const bf16_t* gg = (const bf16_t*)(p.ws + WS_GG); bf16_t* y = (bf16_t*)(p.ws + WS_HBUF);
    LAS float* PH = (LAS float*)lds;
    const int t0 = seg * sl;
#define SC_U(w) __uint_as_float((w) << 16)
#define SC_A(w) (1.f - __uint_as_float((w) & 0xffff0000u))
#pragma unroll
    for (int dir = 0; dir < 2; ++dir) {
        const unsigned* AU = (dir ? AU1 : AU0) + (size_t)row0 * D + ch;
        float P = 1.f, H = 0.f; unsigned wv[SB];
#pragma unroll
        for (int e = 0; e < SB; ++e) { const int tok = dir ? t0 + sl - 1 - e : t0 + e; wv[e] = AU[(size_t)tok * D]; }
        for (int s = 0; s < sl; s += SB) {
            unsigned wn[SB];
            if (s + SB < sl) {
#pragma unroll
                for (int e = 0; e < SB; ++e) { const int tok = dir ? t0 + sl - 1 - (s + SB + e) : t0 + s + SB + e; wn[e] = AU[(size_t)tok * D]; }
            }
#pragma unroll
            for (int e = 0; e < SB; ++e) { const float a = SC_A(wv[e]); H = a * H + SC_U(wv[e]); P *= a; }
#pragma unroll
            for (int e = 0; e < SB; ++e) wv[e] = wn[e];
        }
        PH[((dir * 16 + seg) * 32 + (tid & 31)) * 2] = P; PH[((dir * 16 + seg) * 32 + (tid & 31)) * 2 + 1] = H;
    }
    __syncthreads();
    float carry[2];
#pragma unroll
    for (int dir = 0; dir < 2; ++dir) {
        float h = seq < 16 ? 0.f : INP(4)[(size_t)((seq - 16) * 2 + dir) * D + ch];
        for (int k = 0; k < 16; ++k) { const int s2 = dir ? 15 - k : k; const bool pre = dir ? (s2 > seg) : (s2 < seg);
            const float P = PH[((dir * 16 + s2) * 32 + (tid & 31)) * 2], H = PH[((dir * 16 + s2) * 32 + (tid & 31)) * 2 + 1]; if (pre) h = P * h + H; }
        carry[dir] = h;
    }
    {
        const unsigned* AU = AU0 + (size_t)row0 * D + ch; bf16_t* Y = YF + (size_t)row0 * D + ch; float h = carry[0];
        unsigned wv[SB];
#pragma unroll
        for (int e = 0; e < SB; ++e) wv[e] = AU[(size_t)(t0 + e) * D];
        for (int s = 0; s < sl; s += SB) {
            unsigned wn[SB];
            if (s + SB < sl) {
#pragma unroll
                for (int e = 0; e < SB; ++e) wn[e] = AU[(size_t)(t0 + s + SB + e) * D];
            }
#pragma unroll
            for (int e = 0; e < SB; ++e) { h = SC_A(wv[e]) * h + SC_U(wv[e]); Y[(size_t)(t0 + s + e) * D] = (bf16_t)(cvt_pk_bf16(h, 0.f) & 0xffffu); }
#pragma unroll
            for (int e = 0; e < SB; ++e) wv[e] = wn[e];
        }
        if (seq < 16 && seg == 15) p.out[OUT_R + (size_t)(seq * 2 + 0) * D + ch] = h;
    }
    __syncthreads();
    {
        const unsigned* AU = AU1 + (size_t)row0 * D + ch; const bf16_t* Y = YF + (size_t)row0 * D + ch;
        const bf16_t* Gp = gg + (size_t)row0 * D + ch; bf16_t* yo = y + (size_t)row0 * D + ch; float h = carry[1];
        unsigned wv[8]; unsigned yf[8]; unsigned gv[8];
#pragma unroll
        for (int e = 0; e < 8; ++e) { const int tok = t0 + sl - 1 - e; wv[e] = AU[(size_t)tok * D]; yf[e] = Y[(size_t)tok * D]; gv[e] = Gp[(size_t)tok * D]; }
        for (int s = 0; s < sl; s += 8) {
            unsigned wn[8]; unsigned yn[8]; unsigned gn[8];
            if (s + 8 < sl) {
#pragma unroll
                for (int e = 0; e < 8; ++e) { const int tok = t0 + sl - 1 - (s + 8 + e); wn[e] = AU[(size_t)tok * D]; yn[e] = Y[(size_t)tok * D]; gn[e] = Gp[(size_t)tok * D]; }
            }
#pragma unroll
            for (int e = 0; e < 8; ++e) { const int tok = t0 + sl - 1 - (s + e); h = SC_A(wv[e]) * h + SC_U(wv[e]); yo[(size_t)tok * D] = (bf16_t)(cvt_pk_bf16((__uint_as_float(yf[e] << 16) + h) * __uint_as_float(gv[e] << 16), 0.f) & 0xffffu); }
#pragma unroll
            for (int e = 0; e < 8; ++e) { wv[e] = wn[e]; yf[e] = yn[e]; gv[e] = gn[e]; }
        }
        if (seq < 16 && seg == 0) p.out[OUT_R + (size_t)(seq * 2 + 1) * D + ch] = h;
    }
    __syncthreads();
#undef SC_U
#undef SC_A
}
__device__ __forceinline__ void phase_scan(const Params& p, LAS unsigned char* lds) {
    const int G = gridDim.x, b = blockIdx.x;
    int it = b; const int step = (G >= 256) ? (b < 128 ? 100000 : G - 128) : G;
    for (; it < 1152; it += step) {
        const int seq = it < 128 ? 16 + (it >> 6) : (it - 128) >> 6, cbk = it < 128 ? (it & 63) : ((it - 128) & 63);
        scan_item(p, lds, seq, cbk);
    }
}

__device__ __forceinline__ void blr_minigemm(const bf16_t* h, const bf16_t* wt, float* Pl, LAS unsigned char* lds) {
    const int tid = threadIdx.x, lane = tid & 63, w = tid >> 6, fr = lane & 15, fq = lane >> 4;
    LAS float* red = (LAS float*)lds;
    for (int rb = blockIdx.x; rb < MTOK / 32; rb += gridDim.x) {
        const int row0 = rb * 32;
        f32x4 a00 = {0.f, 0.f, 0.f, 0.f}, a01 = a00, a10 = a00, a11 = a00;
#pragma unroll
        for (int ks = 0; ks < 8; ++ks) {
            const int k0 = (w * 8 + ks) * 32 + fq * 8;
            const bf16x8 h0 = *(const bf16x8*)(h + (size_t)(row0 + fr) * D + k0), h1 = *(const bf16x8*)(h + (size_t)(row0 + 16 + fr) * D + k0);
            const bf16x8 w0 = *(const bf16x8*)(wt + (size_t)fr * D + k0), w1 = *(const bf16x8*)(wt + (size_t)(16 + fr) * D + k0);
            a00 = __builtin_amdgcn_mfma_f32_16x16x32_bf16(h0, w0, a00, 0, 0, 0); a01 = __builtin_amdgcn_mfma_f32_16x16x32_bf16(h0, w1, a01, 0, 0, 0);
            a10 = __builtin_amdgcn_mfma_f32_16x16x32_bf16(h1, w0, a10, 0, 0, 0); a11 = __builtin_amdgcn_mfma_f32_16x16x32_bf16(h1, w1, a11, 0, 0, 0);
        }
        *(LAS f32x4*)(red + ((w * 4 + 0) * 64 + lane) * 4) = a00; *(LAS f32x4*)(red + ((w * 4 + 1) * 64 + lane) * 4) = a01;
        *(LAS f32x4*)(red + ((w * 4 + 2) * 64 + lane) * 4) = a10; *(LAS f32x4*)(red + ((w * 4 + 3) * 64 + lane) * 4) = a11;
        __syncthreads();
        if (tid < 256) {
            const int tile = tid >> 6, l = tid & 63, mt = tile >> 1, nt = tile & 1;
            f32x4 sacc = {0.f, 0.f, 0.f, 0.f};
#pragma unroll
            for (int ww = 0; ww < 8; ++ww) sacc += *(const LAS f32x4*)(red + ((ww * 4 + tile) * 64 + l) * 4);
#pragma unroll
            for (int jj = 0; jj < 4; ++jj) Pl[(size_t)(row0 + 16 * mt + 4 * (l >> 4) + jj) * 32 + 16 * nt + (l & 15)] = sacc[jj];
        }
        __syncthreads();
    }
}

#define XB_TMO      128
#define XB_XCNT(j)  (256  + 64 * (j))
#define XB_XSUB(j)  (1280 + 64 * (j))
#define XB_XGEN(j)  (2304 + 64 * (j))
#define XB_TOP      3328
#define XB_TOPGEN   3392
#define XCD_BAR_WORDS 3456
#define XB_SPIN_CAP (1u << 18)
static_assert(XCD_BAR_WORDS * 4 <= SZ_BAR, "barrier words");
__device__ __forceinline__ unsigned xb_ld(unsigned* p)              { return __hip_atomic_load(p, __ATOMIC_RELAXED, __HIP_MEMORY_SCOPE_AGENT); }
__device__ __forceinline__ unsigned xb_add(unsigned* p, unsigned v) { return __hip_atomic_fetch_add(p, v, __ATOMIC_RELAXED, __HIP_MEMORY_SCOPE_AGENT); }
__device__ __forceinline__ unsigned xb_xcc_id() { return (unsigned)__builtin_amdgcn_s_getreg((3 << 11) | 20) & 0xFu; }
#define XB_SPIN(cond, bar) do { unsigned _sp = 0; while (cond) { __builtin_amdgcn_s_sleep(1); \
    if ((++_sp & 255u) == 0u) { if (xb_ld(&(bar)[XB_TMO])) break; if (_sp > XB_SPIN_CAP) { atomicAdd(&(bar)[XB_TMO], 1u); break; } } } } while (0)
struct XcdBarrier { unsigned* bar; unsigned x; volatile LAS unsigned* st; };
__device__ __forceinline__ XcdBarrier xcd_barrier_post(unsigned* bar, volatile LAS unsigned* st) {
    XcdBarrier b; b.bar = bar; b.x = xb_xcc_id(); b.st = st;
    if (threadIdx.x == 0) (void)xb_add(&bar[XB_XCNT(b.x)], 1u);
    return b;
}
__device__ __forceinline__ void xcd_barrier_complete(unsigned* bar, unsigned x, unsigned& nloc, unsigned& nx) {
    const unsigned G = gridDim.x * gridDim.y * gridDim.z;
    unsigned sum, cnt, mine, sp = 0u;
    for (;;) {
        sum = 0u; cnt = 0u; mine = 0u;
#pragma unroll
        for (unsigned j = 0; j < 16; ++j) { const unsigned c = xb_ld(&bar[XB_XCNT(j)]); sum += c; cnt += (c > 0u) ? 1u : 0u; mine = (j == x) ? c : mine; }
        if (sum == G) break;
        __builtin_amdgcn_s_sleep(1);
        if ((++sp & 255u) == 0u) { if (xb_ld(&bar[XB_TMO])) break; if (sp > XB_SPIN_CAP) { atomicAdd(&bar[XB_TMO], 1u); break; } }
    }
    nloc = mine > 0u ? mine : 1u; nx = cnt > 0u ? cnt : 1u;
}
__device__ __forceinline__ void xcd_barrier(const XcdBarrier& b) {
    asm volatile("s_waitcnt vmcnt(0)" ::: "memory");
    __syncthreads();
    if (threadIdx.x == 0) {
        unsigned* bar = b.bar;
        __builtin_amdgcn_s_waitcnt(0);
        unsigned nloc = b.st[0], nx = b.st[1];
        if (nloc == 0u) { xcd_barrier_complete(bar, b.x, nloc, nx); b.st[0] = nloc; b.st[1] = nx; }
        const unsigned old = xb_add(&bar[XB_XSUB(b.x)], 1u);
        const unsigned gen = old / nloc;
        if (old + 1u == (gen + 1u) * nloc) {
            __builtin_amdgcn_fence(__ATOMIC_RELEASE, "agent");
            asm volatile("s_waitcnt vmcnt(0)" ::: "memory");
            const unsigned og = xb_add(&bar[XB_TOP], 1u);
            const unsigned tg = og / nx;
            if (og + 1u == (tg + 1u) * nx) xb_add(&bar[XB_TOPGEN], 1u);
            else XB_SPIN(xb_ld(&bar[XB_TOPGEN]) == tg, bar);
            __builtin_amdgcn_fence(__ATOMIC_ACQUIRE, "agent");
            xb_add(&bar[XB_XGEN(b.x)], 1u);
            asm volatile("s_waitcnt vmcnt(0)" ::: "memory");
        } else {
            XB_SPIN(xb_ld(&bar[XB_XGEN(b.x)]) == gen, bar);
            __builtin_amdgcn_fence(__ATOMIC_ACQUIRE, "agent");
            asm volatile("s_waitcnt vmcnt(0)" ::: "memory");
        }
    }
    __syncthreads();
}

__global__ void __launch_bounds__(NTHREADS, 2) mega_fwd(Params p) {
    extern __shared__ __attribute__((aligned(16))) unsigned char lds_raw[];
    LAS unsigned char* lds = (LAS unsigned char*)lds_raw;
    cg::grid_group grid = cg::this_grid();
    unsigned char* ws = p.ws;
    const float* mod = (const float*)(ws + WS_MOD);
    bf16_t* hbuf = (bf16_t*)(ws + WS_HBUF); float* xbuf = (float*)(ws + WS_XBUF); bf16_t* act = (bf16_t*)(ws + WS_ACT);
    const int G = gridDim.x, bid = blockIdx.x;
    const int lo = p.ph_lo, hi = p.ph_hi;
    if (lo < 0) grid.sync();
    XcdBarrier xbar; xbar.bar = (unsigned*)(ws + WS_BAR); xbar.x = 0; xbar.st = (volatile LAS unsigned*)(lds + 131072);
    if (hi - lo > 1) {
        if (threadIdx.x < 4) ((LAS unsigned*)(lds + 131072))[threadIdx.x] = 0u;
        __syncthreads();
        xbar = xcd_barrier_post((unsigned*)(ws + WS_BAR), (volatile LAS unsigned*)(lds + 131072));
    }
#define FUSEDN(k) ((k) == 7 || (k) == 10 || (k) == 16 || (k) == 19)
#define IN(k) (EN(k) && !FUSEDN(k) && lo <= (k) && (k) < hi)
#define SEAM(k) do { if ((k) + 1 < hi) xcd_barrier(xbar); } while (0)
    if (IN(0)) {
#if EN(0)
        phase0(p, lds);
#endif
        SEAM(0);
    }
    if (IN(1)) {
#if EN(1)
        phase_normmod(INP(0), INP(1), INP(7), mod + 0 * 2048, mod + 1 * 2048, hbuf);
#endif
        SEAM(1);
    }
    if (IN(2)) {
#if EN(2)
        blr_minigemm(hbuf, (const bf16_t*)(ws + WS_WT_EVEN_IN) + (size_t)8192 * D, (float*)(ws + WS_PL), lds);
        { pg8::Gemm g{hbuf, (const bf16_t*)(ws + WS_WT_EVEN_IN), MTOK, 8192, D, D, 0}; pg8::StaticOrder S; S.init(MTOK, 8192, G, bid);
            EpiEvenIn E{(bf16_t*)(ws + WS_PB), (float*)(ws + WS_PG), (float*)(ws + WS_PL), (const float*)(ws + WS_LB)}; pg8::gemm_phase(lds, g, S, E); }
#endif
        SEAM(2);
    }
    if (IN(3)) {
#if EN(3)
        phase_gateprep(p, lds);
#endif
        SEAM(3);
    }
    if (IN(4)) {
#if EN(4)
        phase_mixer(p, lds);
#endif
        SEAM(4);
    }
    if (IN(5)) {
#if EN(5)
        phase_combine(p);
#endif
        SEAM(5);
    }
    if (IN(6)) {
#if EN(6)
        { pg8::Gemm g{hbuf, (const bf16_t*)(ws + WS_WT_EVEN_OUT), MTOK, D, D, D, 0}; pg8::StaticOrder S; S.init(MTOK, D, G, bid);
            EpiResidNorm E{INP(0), INP(1), xbuf, mod + 2 * 2048, (float*)(ws + WS_NS + SZ_NS_CNT) + (size_t)0 * 8192 * 8, (unsigned*)(ws + WS_NS) + 0 * 2048, INP(8), mod + 3 * 2048, mod + 4 * 2048, hbuf, nullptr, lds, 1}; pg8::gemm_phase(lds, g, S, E); }
#endif
        SEAM(6);
    }
    if (IN(7)) {
#if EN(7)
        phase_normmod(xbuf, xbuf + (size_t)NPR * D, INP(8), mod + 3 * 2048, mod + 4 * 2048, hbuf);
#endif
        SEAM(7);
    }
    if (IN(8)) {
#if EN(8)
        { pg8::Gemm g{hbuf, (const bf16_t*)(ws + WS_WT_FFN_IN0), MTOK, 2 * DFF, D, D, 0}; pg8::StaticOrder S; S.init(MTOK, 2 * DFF, G, bid);
            EpiSwiglu E{act}; pg8::gemm_phase(lds, g, S, E); }
        if (G == 256) { if (bid >= 128) modulation_tasks(p, lds, 1, bid - 128, 128); }
        else modulation_tasks(p, lds, 1, bid, G);
#endif
        SEAM(8);
    }
    if (IN(9)) {
#if EN(9)
        { pg8::Gemm g{act, (const bf16_t*)(ws + WS_WT_FFN_OUT0), MTOK, D, DFF, DFF, 0}; pg8::StaticOrder S; S.init(MTOK, D, G, bid);
            EpiResidNorm E{xbuf, xbuf + (size_t)NPR * D, xbuf, mod + 5 * 2048, (float*)(ws + WS_NS + SZ_NS_CNT) + (size_t)1 * 8192 * 8, (unsigned*)(ws + WS_NS) + 1 * 2048, INP(7) + D, mod + 3 * 12288 + 0 * 2048, mod + 3 * 12288 + 1 * 2048, hbuf, nullptr, lds, 1}; pg8::gemm_phase(lds, g, S, E); }
#endif
        SEAM(9);
    }
    if (IN(10)) {
#if EN(10)
        phase_normmod(xbuf, xbuf + (size_t)NPR * D, INP(7) + D, mod + 3 * 12288 + 0 * 2048, mod + 3 * 12288 + 1 * 2048, hbuf);
#endif
        SEAM(10);
    }
    if (IN(11)) {
#if EN(11)
        { pg8::Gemm g{hbuf, (const bf16_t*)(ws + WS_WT_ODD_IN), MTOK, 4096, D, D, 0}; pg8::StaticOrder S; S.init(MTOK, 4096, G, bid);
            EpiOddIn E{(bf16_t*)(ws + WS_XR), (bf16_t*)(ws + WS_GG)}; pg8::gemm_phase(lds, g, S, E); }
#endif
        SEAM(11);
    }
    if (IN(12)) {
#if EN(12)
        phase_conv(p);
#endif
        SEAM(12);
    }
    if (IN(13)) {
#if EN(13)
        { pg8::Gemm g{(const bf16_t*)(ws + WS_XCB), (const bf16_t*)(ws + WS_WT_GATE), MTOK, 8192, 256, D, 1}; pg8::StaticOrder S; S.init(MTOK, 8192, G, bid);
            EpiGate E{(const bf16_t*)(ws + WS_XCB), INP(24), INP(26), INP(27), (unsigned*)(ws + WS_XR), (unsigned*)(ws + WS_UF)}; pg8::gemm_phase(lds, g, S, E); }
#endif
        SEAM(13);
    }
    if (IN(14)) {
#if EN(14)
        phase_scan(p, lds);
#endif
        SEAM(14);
    }
    if (IN(15)) {
#if EN(15)
        { pg8::Gemm g{hbuf, (const bf16_t*)(ws + WS_WT_ODD_OUT), MTOK, D, D, D, 0}; pg8::StaticOrder S; S.init(MTOK, D, G, bid);
            EpiResidNorm E{xbuf, xbuf + (size_t)NPR * D, xbuf, mod + 3 * 12288 + 2 * 2048, (float*)(ws + WS_NS + SZ_NS_CNT) + (size_t)2 * 8192 * 8, (unsigned*)(ws + WS_NS) + 2 * 2048, INP(8) + D, mod + 3 * 12288 + 3 * 2048, mod + 3 * 12288 + 4 * 2048, hbuf, nullptr, lds, 1}; pg8::gemm_phase(lds, g, S, E); }
#endif
        SEAM(15);
    }
    if (IN(16)) {
#if EN(16)
        phase_normmod(xbuf, xbuf + (size_t)NPR * D, INP(8) + D, mod + 3 * 12288 + 3 * 2048, mod + 3 * 12288 + 4 * 2048, hbuf);
#endif
        SEAM(16);
    }
    if (IN(17)) {
#if EN(17)
        { pg8::Gemm g{hbuf, (const bf16_t*)(ws + WS_WT_FFN_IN1), MTOK, 2 * DFF, D, D, 0}; pg8::StaticOrder S; S.init(MTOK, 2 * DFF, G, bid);
            EpiSwiglu E{act}; pg8::gemm_phase(lds, g, S, E); }
#endif
        SEAM(17);
    }
    if (IN(18)) {
#if EN(18)
        { pg8::Gemm g{act, (const bf16_t*)(ws + WS_WT_FFN_OUT1), MTOK, D, DFF, DFF, 0}; pg8::StaticOrder S; S.init(MTOK, D, G, bid);
            EpiResidNorm E{xbuf, xbuf + (size_t)NPR * D, xbuf, mod + 3 * 12288 + 5 * 2048, (float*)(ws + WS_NS + SZ_NS_CNT) + (size_t)3 * 8192 * 8, (unsigned*)(ws + WS_NS) + 3 * 2048, INP(29), nullptr, nullptr, nullptr, p.out + OUT_Y, lds, hi > 1000}; pg8::gemm_phase(lds, g, S, E); }
#endif
        SEAM(18);
    }
    if (IN(19)) {
#if EN(19)
        phase_finalnorm(xbuf, INP(29), p.out + OUT_Y);
#endif
        SEAM(19);
    }
#ifdef DBG_STOP
#ifndef DBG_OFF
#define DBG_OFF 0
#endif
#ifndef DBG_STRIDE
#define DBG_STRIDE 1
#endif
    if (lo == 99) {
        const unsigned* src = (const unsigned*)(ws + (size_t)DBG_OFF);
        const size_t nout = (size_t)MTOK * D + 2 * 4194304 + 65536;
        for (size_t j = (size_t)blockIdx.x * NTHREADS + threadIdx.x; j < nout / 2; j += (size_t)gridDim.x * NTHREADS) { const unsigned w = (j * DBG_STRIDE < (size_t)DBG_NW) ? src[j * DBG_STRIDE] : 0u; p.out[2 * j] = (float)(w & 0xffffu); p.out[2 * j + 1] = (float)(w >> 16); }
    }
#endif
#undef IN
#undef SEAM
}

extern "C" void kernel_launch(void* const* d_in, const int* in_sizes, int n_in, void* d_out, int out_size, void* d_ws, size_t ws_size, hipStream_t stream) {
    static int grid = 0;
    if (grid == 0) {
        if (n_in != 30 || ws_size < WS_END) { fprintf(stderr, "kernel_launch: need 30 inputs and >= %zu bytes of workspace (got %d, %zu)\n", (size_t)WS_END, n_in, ws_size); grid = -1; return; }
        int dev = 0, cus = 0, per_cu = 0;
        if (hipGetDevice(&dev) != hipSuccess || hipDeviceGetAttribute(&cus, hipDeviceAttributeMultiprocessorCount, dev) != hipSuccess) { fprintf(stderr, "kernel_launch: device query failed\n"); grid = -1; return; }
        if (hipFuncSetAttribute((const void*)mega_fwd, hipFuncAttributeMaxDynamicSharedMemorySize, LDS_BYTES) != hipSuccess) { fprintf(stderr, "kernel_launch: hipFuncSetAttribute failed\n"); grid = -1; return; }
        if (hipOccupancyMaxActiveBlocksPerMultiprocessor(&per_cu, (const void*)mega_fwd, NTHREADS, LDS_BYTES) != hipSuccess || per_cu < 1) { fprintf(stderr, "kernel_launch: occupancy query says %d blocks per CU\n", per_cu); per_cu = 1; }
        (void)hipGetLastError();
        grid = cus;
    }
    if (grid < 0) return;
    (void)hipMemsetAsync((char*)d_ws + WS_BAR, 0, SZ_BAR + SZ_NS_CNT, stream);
    Params p{};
    for (int i = 0; i < 30; ++i) p.in[i] = (const float*)d_in[i];
    p.out = (float*)d_out; p.ws = (unsigned char*)d_ws;
#if ONE_LAUNCH
    p.ph_lo = 0; p.ph_hi = NPHASE;
    void* args[] = {&p};
    hipError_t e = hipLaunchCooperativeKernel((const void*)mega_fwd, dim3(grid), dim3(NTHREADS), args, LDS_BYTES, stream);
    if (e != hipSuccess) fprintf(stderr, "kernel_launch: cooperative launch failed: %s (grid %d)\n", hipGetErrorString(e), grid);
#else
#ifdef DBG_STOP
    for (int ph = 0; ph <= DBG_STOP; ++ph) { p.ph_lo = ph; p.ph_hi = ph + 1; hipLaunchKernelGGL(mega_fwd, dim3(grid), dim3(NTHREADS), LDS_BYTES, stream, p); }
    p.ph_lo = 99; p.ph_hi = 100; hipLaunchKernelGGL(mega_fwd, dim3(grid), dim3(NTHREADS), LDS_BYTES, stream, p);
#else
    for (int ph = 0; ph < NPHASE; ++ph) {
        p.ph_lo = ph; p.ph_hi = ph + 1;
        hipLaunchKernelGGL(mega_fwd, dim3(grid), dim3(NTHREADS), LDS_BYTES, stream, p);
    }
#endif
#endif
}
```

```cpp
#include <hip/hip_runtime.h>
#include <hip/hip_cooperative_groups.h>
#include <cstdio>
namespace cg = cooperative_groups;

#ifndef PHMASK
#define PHMASK 0xfffff
#endif
#define EN(k) ((PHMASK >> (k)) & 1)
#ifndef ONE_LAUNCH
#define ONE_LAUNCH 1
#endif

#define LAS __attribute__((address_space(3)))
typedef unsigned short bf16_t;
typedef short bf16x8 __attribute__((ext_vector_type(8)));
typedef float f32x4 __attribute__((ext_vector_type(4)));
typedef unsigned u32x4 __attribute__((ext_vector_type(4)));
typedef unsigned u32x2 __attribute__((ext_vector_type(2)));

constexpr int D = 2048, MTOK = 8192, NPR = 4096;
constexpr int DFF = 5632, NEVEN = 8224, NEVENP = 8448;
constexpr int NTHREADS = 512;
constexpr int LDS_BYTES = 131072 + 16;
constexpr int NPHASE = 20;

constexpr size_t SZ_WT_EVEN_IN = (size_t)NEVENP * D * 2, SZ_WT_SQ = (size_t)D * D * 2, SZ_WT_FFN_IN = (size_t)2 * DFF * D * 2, SZ_WT_FFN_OUT = (size_t)D * DFF * 2;
constexpr size_t WS_WT_EVEN_IN = 0;
constexpr size_t WS_WT_EVEN_OUT = WS_WT_EVEN_IN + SZ_WT_EVEN_IN;
constexpr size_t WS_WT_FFN_IN0 = WS_WT_EVEN_OUT + SZ_WT_SQ;
constexpr size_t WS_WT_FFN_OUT0 = WS_WT_FFN_IN0 + SZ_WT_FFN_IN;
constexpr size_t WS_WT_FFN_IN1 = WS_WT_FFN_OUT0 + SZ_WT_FFN_OUT;
constexpr size_t WS_WT_FFN_OUT1 = WS_WT_FFN_IN1 + SZ_WT_FFN_IN;
constexpr size_t WS_WT_ODD_IN = WS_WT_FFN_OUT1 + SZ_WT_FFN_OUT;
constexpr size_t WS_WT_GATE = WS_WT_ODD_IN + (size_t)4096 * D * 2;
constexpr size_t WS_WT_ODD_OUT = WS_WT_GATE + (size_t)8192 * 256 * 2;
constexpr size_t WS_MOD = WS_WT_ODD_OUT + SZ_WT_SQ;
constexpr size_t SZ_MOD = (size_t)2 * 3 * 12288 * 4;
constexpr size_t WS_LB = WS_MOD + SZ_MOD;
constexpr size_t WS_BAR = WS_LB + 4096;
constexpr size_t SZ_BAR = 16384;
constexpr size_t WS_NS = WS_BAR + SZ_BAR;
constexpr size_t SZ_NS_CNT = 4 * 32 * 64 * 4;
constexpr size_t SZ_NS = SZ_NS_CNT + (size_t)4 * 8192 * 8 * 4;
constexpr size_t WS_HBUF = WS_NS + SZ_NS;
constexpr size_t SZ_ACT_F32 = (size_t)MTOK * D * 4, SZ_ACT_BF = (size_t)MTOK * D * 2;
constexpr size_t WS_XBUF = WS_HBUF + SZ_ACT_BF;
constexpr size_t WS_ACT = WS_XBUF + SZ_ACT_F32;
constexpr size_t WS_R = WS_ACT + (size_t)MTOK * DFF * 2;
constexpr size_t WS_PB = WS_R;
constexpr size_t WS_PG = WS_PB + (size_t)MTOK * 8192 * 2;
constexpr size_t WS_PL = WS_PG + SZ_ACT_F32;
constexpr size_t WS_OF = WS_PL + (size_t)MTOK * 32 * 4;
constexpr size_t WS_OB = WS_OF + SZ_ACT_F32;
constexpr size_t WS_R_END0 = WS_OB + SZ_ACT_F32;
constexpr size_t WS_XR = WS_R;
constexpr size_t WS_GG = WS_XR + SZ_ACT_F32;
constexpr size_t WS_XCB = WS_GG + SZ_ACT_BF;
constexpr size_t WS_UF = WS_XCB + SZ_ACT_BF;
constexpr size_t WS_AB = WS_UF + SZ_ACT_F32;
constexpr size_t WS_UB = WS_AB + SZ_ACT_F32;
constexpr size_t WS_R_END1 = WS_UB + SZ_ACT_F32;
constexpr size_t WS_END = (WS_R_END0 > WS_R_END1 ? WS_R_END0 : WS_R_END1);
constexpr size_t WS_XC = WS_WT_EVEN_IN;
static_assert(WS_WT_FFN_IN1 - WS_WT_EVEN_IN >= SZ_ACT_F32, "xc alias");

constexpr size_t OUT_Y = 0, OUT_H = (size_t)MTOK * D, OUT_G = OUT_H + (size_t)16 * 2 * 8 * 128 * 128, OUT_R = OUT_G + (size_t)16 * 2 * 4 * 128 * 256;

struct Params { const float* in[30]; float* out; unsigned char* ws; int ph_lo, ph_hi; };

__device__ __forceinline__ const float* in_ptr_(int byte_off) {
    const char* ka = (const char*)__builtin_amdgcn_kernarg_segment_ptr(); unsigned long long v;
    asm volatile("s_load_dwordx2 %0, %1, %2\n\ts_waitcnt lgkmcnt(0)" : "=s"(v) : "s"(ka), "i"(byte_off) : "memory");
    return (const float*)v;
}
#define INP(k) in_ptr_((k) * 8)
typedef __bf16 bf16v2_t __attribute__((ext_vector_type(2)));
typedef float f32x2_t __attribute__((ext_vector_type(2)));
__device__ __forceinline__ unsigned cvt_pk_bf16(float lo, float hi) { const f32x2_t v = {lo, hi}; const bf16v2_t b = __builtin_convertvector(v, bf16v2_t); return __builtin_bit_cast(unsigned, b); }
__device__ __forceinline__ float bf2f(bf16_t b) { return __uint_as_float(((unsigned)b) << 16); }
__device__ __forceinline__ float sigm(float x) { return __builtin_amdgcn_rcpf(1.f + __expf(-x)); }
__device__ __forceinline__ float gelu_tanh(float x) { const float u = 0.7978845608028654f * (x + 0.044715f * x * x * x); const float t = 1.f - 2.f * __builtin_amdgcn_rcpf(1.f + __expf(2.f * u)); return 0.5f * x * (1.f + t); }
__device__ __forceinline__ float wave_sum(float v) { for (int o = 32; o >= 1; o >>= 1) v += __shfl_xor(v, o); return v; }
__device__ __forceinline__ int row_cvec(int row) { return row < NPR ? 0 : 1 + ((row - NPR) >> 11); }

namespace pg8 {
constexpr int BM = 256, BK = 64, HALF = 128, HTB = HALF * BK * 2, NXCD = 8, WGM = 8;
__device__ __forceinline__ int lds_byte(int r, int c) { const int st = (r >> 4) * 2 + (c >> 5), rr = r & 15, cc = c & 31, ob = rr * 64 + cc * 2; return st * 1024 + (ob ^ (((ob >> 9) & 1) << 5)); }
__device__ __forceinline__ void stage_rc(int b, int& R, int& C) { const int st = b / 1024, sb = b % 1024, swz = sb ^ (((sb >> 9) & 1) << 5); R = (st >> 1) * 16 + swz / 64; C = (st & 1) * 32 + (swz % 64) / 2; }
struct Unit { int pm, pn; };
struct Gemm { const bf16_t* A; const bf16_t* Bt; int M, N, K, lda, amode; };
struct StaticOrder {
    int nM, nN, nwg, G, c;
    __device__ void init(int M, int N, int G_, int c_) { nM = M / BM; nN = N / BM; nwg = nM * nN; G = G_; c = c_; }
    __device__ bool next(int i, Unit& u) const {
        const long L = (long)i * G + c; if (L >= nwg) return false;
        int wgid = (int)L; { const int q = nwg / NXCD, r = nwg % NXCD, xcd = wgid % NXCD, off = wgid / NXCD; wgid = (xcd < r ? xcd * (q + 1) : r * (q + 1) + (xcd - r) * q) + off; }
        const int nig = WGM * nN, gid = wgid / nig, fm = gid * WGM, gsz = (nM - fm) < WGM ? (nM - fm) : WGM;
        u.pm = fm + ((wgid % nig) % gsz); u.pn = (wgid % nig) / gsz; return true;
    }
};
__device__ __forceinline__ const char* a_base(const Gemm& g, const Unit& u) {
    size_t off = (size_t)u.pm * BM * g.lda;
    if (g.amode == 1) off += (size_t)((u.pn & 15) >> 1) * 256;
    return (const char*)g.A + off * 2;
}

template <class Epi>
__device__ __forceinline__ void gemm_phase(LAS unsigned char* lds, const Gemm g, const StaticOrder& S, const Epi& E) {
    const int tid = threadIdx.x, wid = __builtin_amdgcn_readfirstlane(tid >> 6), lane = tid & 63, wr = wid >> 2, wc = wid & 3, fr = lane & 15, fq = lane >> 4;
    const int K = g.K, nt = K / BK;
    unsigned voffA[2], voffB[2];
#pragma unroll
    for (int i = 0; i < 2; ++i) { int R, C; stage_rc(tid * 16 + i * 8192, R, C);
        voffA[i] = (unsigned)(R * g.lda + C) * 2u; voffB[i] = (unsigned)(R * K + C) * 2u; }
    const size_t kstep = (size_t)(BK * 2);
    const size_t hstepA = (size_t)HALF * g.lda * 2, hstepB = (size_t)HALF * K * 2;
    const unsigned ldsw = (unsigned)wid * 1024u;
    const int aoff = lds_byte(wr * 64 + fr, fq * 8), boff = lds_byte(wc * 32 + fr, fq * 8);
#define PG8_SA(b, h) (((b) * 2 + (h)) * HTB)
#define PG8_SB(b, h) ((4 + (b) * 2 + (h)) * HTB)
#define PG8_STAGE(bufoff, gbase, voff) do { _Pragma("unroll") for (int _i = 0; _i < 2; ++_i) \
        __builtin_amdgcn_global_load_lds((const unsigned*)((const char*)(gbase) + (voff)[_i]), (LAS unsigned*)(lds + (bufoff) + ldsw + _i * 8192), 16, 0, 0); } while (0)
#define PG8_LDA(dst, b, h) do { _Pragma("unroll") for (int m = 0; m < 4; ++m) _Pragma("unroll") for (int k = 0; k < 2; ++k) dst[m][k] = *(const LAS bf16x8*)(lds + PG8_SA(b, h) + aoff + m * 2048 + k * 1024); } while (0)
#define PG8_LDB(dst, b, h) do { _Pragma("unroll") for (int n = 0; n < 2; ++n) _Pragma("unroll") for (int k = 0; k < 2; ++k) dst[n][k] = *(const LAS bf16x8*)(lds + PG8_SB(b, h) + boff + n * 2048 + k * 1024); } while (0)
#define PG8_MMA(ai, bj, At, Bt) do { __builtin_amdgcn_s_setprio(1); _Pragma("unroll") for (int m = 0; m < 4; ++m) _Pragma("unroll") for (int n = 0; n < 2; ++n) _Pragma("unroll") for (int k = 0; k < 2; ++k) \
        acc[ai][bj][m][n] = __builtin_amdgcn_mfma_f32_16x16x32_bf16(Bt[n][k], At[m][k], acc[ai][bj][m][n], 0, 0, 0); __builtin_amdgcn_s_setprio(0); } while (0)
#define PG8_WAIT_V(n) asm volatile("s_waitcnt vmcnt(" #n ")" ::: "memory")
#define PG8_WAIT_L(n) asm volatile("s_waitcnt lgkmcnt(" #n ")" ::: "memory")
#define PG8_BAR __builtin_amdgcn_s_barrier()
#define PG8_SCHED __builtin_amdgcn_sched_barrier(0)
    Unit cur, nxt; int ui = 0;
    if (!S.next(0, cur)) return;
    f32x4 acc[2][2][4][2];
#pragma unroll
    for (int a = 0; a < 2; ++a)
#pragma unroll
        for (int b = 0; b < 2; ++b)
#pragma unroll
            for (int m = 0; m < 4; ++m)
#pragma unroll
                for (int n = 0; n < 2; ++n) acc[a][b][m][n] = (f32x4){0.f, 0.f, 0.f, 0.f};
    bf16x8 At[4][2], B0[2][2], B1[2][2];
    const char* cA = a_base(g, cur); const char* cB = (const char*)g.Bt + (size_t)cur.pn * BM * K * 2;
    PG8_STAGE(PG8_SB(0, 0), cB, voffB); PG8_STAGE(PG8_SA(0, 0), cA, voffA); PG8_STAGE(PG8_SB(0, 1), cB + hstepB, voffB); PG8_STAGE(PG8_SA(0, 1), cA + hstepA, voffA);
    if (wr == 1) PG8_BAR;
    PG8_WAIT_V(4); PG8_BAR;
    PG8_STAGE(PG8_SB(1, 0), cB + kstep, voffB); PG8_STAGE(PG8_SA(1, 0), cA + kstep, voffA); PG8_STAGE(PG8_SB(1, 1), cB + hstepB + kstep, voffB);
    PG8_WAIT_V(6); PG8_BAR;
    for (;;) {
        const bool has_next = S.next(ui + 1, nxt);
        const char* nA = has_next ? a_base(g, nxt) : cA; const char* nB = has_next ? (const char*)g.Bt + (size_t)nxt.pn * BM * K * 2 : cB;
#pragma unroll 1
        for (int t = 0; t < nt; t += 2) {
            const bool last = (t == nt - 2);
            const char* a1 = cA + (size_t)(t + 1) * kstep;
            const char* a2 = last ? nA : cA + (size_t)(t + 2) * kstep; const char* b2 = last ? nB : cB + (size_t)(t + 2) * kstep;
            const char* a3 = a2 + kstep; const char* b3 = b2 + kstep;
            PG8_LDB(B0, 0, 0); PG8_SCHED; PG8_LDA(At, 0, 0); PG8_STAGE(PG8_SA(1, 1), a1 + hstepA, voffA);
            PG8_WAIT_L(8); PG8_BAR; PG8_WAIT_L(0); PG8_MMA(0, 0, At, B0); PG8_BAR; PG8_SCHED;
            PG8_LDB(B1, 0, 1); PG8_STAGE(PG8_SB(0, 0), b2, voffB);
            PG8_BAR; PG8_WAIT_L(0); PG8_MMA(0, 1, At, B1); PG8_BAR;
            PG8_LDA(At, 0, 1); PG8_STAGE(PG8_SA(0, 0), a2, voffA);
            PG8_BAR; PG8_WAIT_L(0); PG8_MMA(1, 0, At, B0); PG8_BAR; PG8_SCHED;
            PG8_STAGE(PG8_SB(0, 1), b2 + hstepB, voffB);
            PG8_WAIT_V(6); PG8_BAR; PG8_MMA(1, 1, At, B1); PG8_BAR;
            PG8_LDB(B0, 1, 0); PG8_SCHED; PG8_LDA(At, 1, 0); PG8_STAGE(PG8_SA(0, 1), a2 + hstepA, voffA);
            PG8_WAIT_L(8); PG8_BAR; PG8_WAIT_L(0); PG8_MMA(0, 0, At, B0); PG8_BAR; PG8_SCHED;
            PG8_LDB(B1, 1, 1); PG8_STAGE(PG8_SB(1, 0), b3, voffB);
            PG8_BAR; PG8_WAIT_L(0); PG8_MMA(0, 1, At, B1); PG8_BAR;
            PG8_LDA(At, 1, 1); PG8_STAGE(PG8_SA(1, 0), a3, voffA);
            PG8_BAR; PG8_WAIT_L(0); PG8_MMA(1, 0, At, B0); PG8_BAR; PG8_SCHED;
            PG8_STAGE(PG8_SB(1, 1), b3 + hstepB, voffB);
            PG8_WAIT_V(6); PG8_BAR; PG8_MMA(1, 1, At, B1); PG8_BAR;
        }
        if constexpr (!Epi::AFTER_DRAIN) E(acc, cur, wr, wc, fr, fq);
        if (!has_next) break;
#pragma unroll
        for (int a = 0; a < 2; ++a)
#pragma unroll
            for (int b = 0; b < 2; ++b)
#pragma unroll
                for (int m = 0; m < 4; ++m)
#pragma unroll
                    for (int n = 0; n < 2; ++n) acc[a][b][m][n] = (f32x4){0.f, 0.f, 0.f, 0.f};
        cur = nxt; cA = nA; cB = nB; ++ui;
    }
    PG8_WAIT_V(0);
    if (wr == 0) PG8_BAR;
    PG8_BAR;
    if constexpr (Epi::AFTER_DRAIN) E(acc, cur, wr, wc, fr, fq);
#undef PG8_SA
#undef PG8_SB
#undef PG8_STAGE
#undef PG8_LDA
#undef PG8_LDB
#undef PG8_MMA
#undef PG8_WAIT_V
#undef PG8_WAIT_L
#undef PG8_BAR
#undef PG8_SCHED
}
}

#define EPI_ARGS const f32x4 (&acc)[2][2][4][2], const pg8::Unit& u, int wr, int wc, int fr, int fq
struct EpiEvenIn {
    static constexpr bool AFTER_DRAIN = false;
    bf16_t* Pb; float* Pg; float* Pl; const float* lb;
    __device__ __forceinline__ void operator()(EPI_ARGS) const {
        const int row0 = u.pm * 256 + wr * 64 + fr, pn = u.pn;
        if (pn >= 4 && pn < 12) {
#pragma unroll
            for (int bj = 0; bj < 2; ++bj)
#pragma unroll
                for (int n = 0; n < 2; ++n) {
                    const int gc = pn * 256 + bj * 128 + wc * 32 + n * 16 + 4 * fq - 1024;
                    const f32x4 l4 = *(const f32x4*)(lb + (gc & 1023));
#pragma unroll
                    for (int ai = 0; ai < 2; ++ai)
#pragma unroll
                        for (int m = 0; m < 4; ++m) {
                            const f32x4 v = acc[ai][bj][m][n]; f32x4 o;
#pragma unroll
                            for (int e = 0; e < 4; ++e) o[e] = __logf(l4[e] + (1.f - l4[e]) * sigm(v[e]));
                            *(f32x4*)(Pg + (size_t)(row0 + ai * 128 + m * 16) * 2048 + gc) = o;
                        }
                }
        } else if (pn == 32) {
            if (wc == 0) {
#pragma unroll
                for (int n = 0; n < 2; ++n)
#pragma unroll
                    for (int ai = 0; ai < 2; ++ai)
#pragma unroll
                        for (int m = 0; m < 4; ++m) *(f32x4*)(Pl + (size_t)(row0 + ai * 128 + m * 16) * 32 + n * 16 + 4 * fq) = acc[ai][0][m][n];
            }
        } else {
            const float sc = (pn < 4 || pn == 20 || pn == 21) ? 0.08838834764831845f : 1.f;
#pragma unroll
            for (int bj = 0; bj < 2; ++bj)
#pragma unroll
                for (int n = 0; n < 2; ++n) {
                    const int c = pn * 256 + bj * 128 + wc * 32 + n * 16 + 4 * fq;
#pragma unroll
                    for (int ai = 0; ai < 2; ++ai)
#pragma unroll
                        for (int m = 0; m < 4; ++m) {
                            const f32x4 v = acc[ai][bj][m][n] * sc; u32x2 w; w.x = cvt_pk_bf16(v[0], v[1]); w.y = cvt_pk_bf16(v[2], v[3]);
                            *(u32x2*)(Pb + (size_t)(row0 + ai * 128 + m * 16) * 8192 + c) = w;
                        }
                }
        }
    }
};
struct EpiResid {
    static constexpr bool AFTER_DRAIN = false;
    const float* r0; const float* r1; float* out; const float* gate;
    __device__ __forceinline__ void operator()(EPI_ARGS) const {
        const int row0 = u.pm * 256 + wr * 64 + fr; const int v = row_cvec(u.pm * 256);
        const float* src = (u.pm * 256 < NPR) ? r0 + (size_t)row0 * D : r1 + (size_t)(row0 - NPR) * D;
#pragma unroll
        for (int bj = 0; bj < 2; ++bj)
#pragma unroll
            for (int n = 0; n < 2; ++n) {
                const int c = u.pn * 256 + bj * 128 + wc * 32 + n * 16 + 4 * fq;
                const f32x4 gv = *(const f32x4*)(gate + v * 12288 + c);
#pragma unroll
                for (int ai = 0; ai < 2; ++ai)
#pragma unroll
                    for (int m = 0; m < 4; ++m) {
                        const size_t ro = (size_t)(ai * 128 + m * 16) * D + c;
                        const f32x4 x = *(const f32x4*)(src + ro);
                        *(f32x4*)(out + (size_t)row0 * D + ro) = x + gv * acc[ai][bj][m][n];
                    }
            }
    }
};
struct EpiResidNorm {
    static constexpr bool AFTER_DRAIN = true;
    const float* r0; const float* r1; float* xout; const float* gate; float* slots; unsigned* cnt; const float* ng; const float* sh; const float* sc; bf16_t* hout; float* yout; LAS unsigned char* lds; int store_x;
    __device__ __forceinline__ void operator()(f32x4 (&acc)[2][2][4][2], const pg8::Unit& u, int wr, int wc, int fr, int fq) const {
        const int row0 = u.pm * 256 + wr * 64 + fr; const int v = row_cvec(u.pm * 256);
        const float* src = (u.pm * 256 < NPR) ? r0 + (size_t)row0 * D : r1 + (size_t)(row0 - NPR) * D;
#pragma unroll
        for (int bj = 0; bj < 2; ++bj)
#pragma unroll
            for (int n = 0; n < 2; ++n) {
                const int c = u.pn * 256 + bj * 128 + wc * 32 + n * 16 + 4 * fq;
                const f32x4 gv = *(const f32x4*)(gate + v * 12288 + c);
#pragma unroll
                for (int ai = 0; ai < 2; ++ai)
#pragma unroll
                    for (int m = 0; m < 4; ++m) {
                        const unsigned ro = (unsigned)((ai * 128 + m * 16) * D + c);
                        const f32x4 x = *(const f32x4*)(src + ro) + gv * acc[ai][bj][m][n];
                        acc[ai][bj][m][n] = x;
                        if (store_x) __builtin_nontemporal_store(x, (f32x4*)(xout + (size_t)row0 * D + ro));
                        if (m & 1) { asm volatile("" ::: "memory"); __builtin_amdgcn_sched_barrier(0); }
                    }
            }
        LAS float* Pt = (LAS float*)lds;
        LAS float* Rt = (LAS float*)(lds + 4096);
#pragma unroll
        for (int ai = 0; ai < 2; ++ai)
#pragma unroll
            for (int m = 0; m < 4; ++m) {
                float ssq = 0.f;
#pragma unroll
                for (int bj = 0; bj < 2; ++bj)
#pragma unroll
                    for (int n = 0; n < 2; ++n) { const f32x4 x = acc[ai][bj][m][n]; ssq += (x[0] * x[0] + x[1] * x[1]) + (x[2] * x[2] + x[3] * x[3]); }
                ssq += __shfl_xor(ssq, 16); ssq += __shfl_xor(ssq, 32);
                if (fq == 0) Pt[(ai * 128 + wr * 64 + m * 16 + fr) * 4 + wc] = ssq;
            }
        __syncthreads();
        float* myslots = slots + (size_t)(u.pm * 256) * 8;
        if (threadIdx.x < 256) {
            const f32x4 p4 = *(const LAS f32x4*)(Pt + threadIdx.x * 4);
            __hip_atomic_store(myslots + threadIdx.x * 8 + u.pn, (p4[0] + p4[1]) + (p4[2] + p4[3]), __ATOMIC_RELAXED, __HIP_MEMORY_SCOPE_AGENT);
        }
        asm volatile("s_waitcnt vmcnt(0)" ::: "memory");
        __syncthreads();
        if (threadIdx.x == 0) {
            unsigned* cw = cnt + u.pm * 64;
            (void)__hip_atomic_fetch_add(cw, 1u, __ATOMIC_RELAXED, __HIP_MEMORY_SCOPE_AGENT);
            unsigned spins = 0;
            while (__hip_atomic_load(cw, __ATOMIC_RELAXED, __HIP_MEMORY_SCOPE_AGENT) < 8u) { __builtin_amdgcn_s_sleep(2); if (++spins > (1u << 22)) break; }
        }
        __syncthreads();
        __builtin_amdgcn_fence(__ATOMIC_ACQUIRE, "agent");
        if (threadIdx.x < 256) {
            float ss = 0.f;
#pragma unroll
            for (int t = 0; t < 8; ++t) ss += __hip_atomic_load(myslots + threadIdx.x * 8 + t, __ATOMIC_RELAXED, __HIP_MEMORY_SCOPE_AGENT);
            Rt[threadIdx.x] = rsqrtf(ss * (1.f / D) + 1e-6f);
        }
        __syncthreads();
        float rinv[2][4];
#pragma unroll
        for (int ai = 0; ai < 2; ++ai)
#pragma unroll
            for (int m = 0; m < 4; ++m) rinv[ai][m] = Rt[ai * 128 + wr * 64 + m * 16 + fr];
#pragma unroll
        for (int bj = 0; bj < 2; ++bj)
#pragma unroll
            for (int n = 0; n < 2; ++n) {
                const int c = u.pn * 256 + bj * 128 + wc * 32 + n * 16 + 4 * fq;
                f32x4 g4 = *(const f32x4*)(ng + c), s4 = {0.f, 0.f, 0.f, 0.f};
                if (sh) { g4 = g4 * (*(const f32x4*)(sc + v * 12288 + c) + 1.f); s4 = *(const f32x4*)(sh + v * 12288 + c); }
#pragma unroll
                for (int ai = 0; ai < 2; ++ai)
#pragma unroll
                    for (int m = 0; m < 4; ++m) {
                        const unsigned ro = (unsigned)(row0 + ai * 128 + m * 16) * (unsigned)D + (unsigned)c;
                        const f32x4 o = acc[ai][bj][m][n] * rinv[ai][m] * g4 + s4;
                        if (yout) __builtin_nontemporal_store(o, (f32x4*)(yout + ro));
                        else { u32x2 w; w.x = cvt_pk_bf16(o[0], o[1]); w.y = cvt_pk_bf16(o[2], o[3]); *(u32x2*)(hout + ro) = w; }
                        asm volatile("" ::: "memory"); __builtin_amdgcn_sched_barrier(0);
                    }
            }
    }
};
struct EpiSwiglu {
    static constexpr bool AFTER_DRAIN = false;
    bf16_t* act;
    __device__ __forceinline__ void operator()(EPI_ARGS) const {
        const int row0 = u.pm * 256 + wr * 64 + fr;
#pragma unroll
        for (int n = 0; n < 2; ++n) {
            const int j = u.pn * 128 + wc * 32 + n * 16 + 4 * fq;
#pragma unroll
            for (int ai = 0; ai < 2; ++ai)
#pragma unroll
                for (int m = 0; m < 4; ++m) {
                    const f32x4 gt = acc[ai][0][m][n], up = acc[ai][1][m][n]; f32x4 o;
#pragma unroll
                    for (int e = 0; e < 4; ++e) o[e] = gt[e] * sigm(gt[e]) * up[e];
                    u32x2 w; w.x = cvt_pk_bf16(o[0], o[1]); w.y = cvt_pk_bf16(o[2], o[3]);
                    *(u32x2*)(act + (size_t)(row0 + ai * 128 + m * 16) * DFF + j) = w;
                }
        }
    }
};
struct EpiOddIn {
    static constexpr bool AFTER_DRAIN = false;
    bf16_t* xr; bf16_t* gg;
    __device__ __forceinline__ void operator()(EPI_ARGS) const {
        const int row0 = u.pm * 256 + wr * 64 + fr;
#pragma unroll
        for (int bj = 0; bj < 2; ++bj)
#pragma unroll
            for (int n = 0; n < 2; ++n) {
                const int c = u.pn * 256 + bj * 128 + wc * 32 + n * 16 + 4 * fq;
#pragma unroll
                for (int ai = 0; ai < 2; ++ai)
#pragma unroll
                    for (int m = 0; m < 4; ++m) {
                        const f32x4 v = acc[ai][bj][m][n]; const size_t r = (size_t)(row0 + ai * 128 + m * 16);
                        if (u.pn < 8) { u32x2 w; w.x = cvt_pk_bf16(v[0], v[1]); w.y = cvt_pk_bf16(v[2], v[3]); *(u32x2*)(xr + r * D + c) = w; }
                        else { u32x2 w; w.x = cvt_pk_bf16(gelu_tanh(v[0]), gelu_tanh(v[1])); w.y = cvt_pk_bf16(gelu_tanh(v[2]), gelu_tanh(v[3])); *(u32x2*)(gg + r * D + (c - 2048)) = w; }
                    }
            }
    }
};
struct EpiGate {
    static constexpr bool AFTER_DRAIN = false;
    const bf16_t* xcb; const float* rg_b; const float* ig_b; const float* lam; unsigned* au0; unsigned* au1;
    __device__ __forceinline__ void operator()(EPI_ARGS) const {
        const int dir = u.pn >> 4, cg = u.pn & 15;
        unsigned* au = dir ? au1 : au0;
        const unsigned rowoff = (unsigned)(u.pm * 256 + wr * 64 + fr) * (unsigned)D + (unsigned)(cg * 128 + wc * 32 + 4 * fq);
        const int chb = dir * D + cg * 128 + wc * 32 + 4 * fq;
#pragma unroll
        for (int n = 0; n < 2; ++n) {
            asm volatile("" ::: "memory"); __builtin_amdgcn_sched_barrier(0);
            const f32x4 rb = *(const f32x4*)(rg_b + chb + n * 16), ib = *(const f32x4*)(ig_b + chb + n * 16), lm = *(const f32x4*)(lam + chb + n * 16);
            f32x4 sp;
#pragma unroll
            for (int e = 0; e < 4; ++e) { const float t = __expf(-lm[e]); sp[e] = -8.f * (t < 0.03f ? t * (1.f - t * (0.5f - t * (0.33333334f - 0.25f * t))) : __logf(1.f + t)); }
#pragma unroll
            for (int ai = 0; ai < 2; ++ai)
#pragma unroll
                for (int m = 0; m < 4; ++m) {
                    const unsigned o = rowoff + (unsigned)((ai * 128 + m * 16) * D + n * 16);
                    const u32x2 xw = *(const u32x2*)(xcb + o);
                    const float x0 = __uint_as_float(xw.x << 16), x1 = __uint_as_float(xw.x & 0xffff0000u), x2v = __uint_as_float(xw.y << 16), x3 = __uint_as_float(xw.y & 0xffff0000u);
                    const f32x4 x = {x0, x1, x2v, x3};
                    const f32x4 rp = acc[ai][0][m][n] + rb, ip = acc[ai][1][m][n] + ib; unsigned pk[4];
#pragma unroll
                    for (int e = 0; e < 4; ++e) { const float la = sp[e] * sigm(rp[e]); const float a = __expf(la);
                        const float oma = 1.f - a;
                        pk[e] = cvt_pk_bf16(__builtin_amdgcn_sqrtf(oma * (1.f + a)) * sigm(ip[e]) * x[e], oma); }
                    *(u32x4*)(au + o) = (u32x4){pk[0], pk[1], pk[2], pk[3]};
                    asm volatile("" ::: "memory"); __builtin_amdgcn_sched_barrier(0);
                }
        }
    }
};

struct ConvTile { const float* src; int ldw; int nvalid; bf16_t* dst; int K; };
__device__ __forceinline__ ConvTile conv_decode(const Params& p, int t) {
    ConvTile c; int m, local;
    if (t < 528) { m = 0; local = t; } else if (t < 656) { m = 1; local = t - 528; } else if (t < 1360) { m = 2; local = t - 656; } else if (t < 2064) { m = 3; local = t - 1360; }
    else if (t < 2416) { m = 4; local = t - 2064; } else if (t < 2768) { m = 5; local = t - 2416; } else if (t < 3024) { m = 6; local = t - 2768; } else if (t < 3088) { m = 7; local = t - 3024; } else { m = 8; local = t - 3088; }
    const int K = (m == 4 || m == 5) ? DFF : (m == 7 ? 256 : D); const int kts = K / 256; const int nb = local / kts, kt = local % kts; const int k0 = kt * 256;
    c.K = K; c.nvalid = 128;
    unsigned char* ws = p.ws;
    switch (m) {
    case 0: { const int col0 = nb * 128; c.src = INP(14) + (size_t)k0 * NEVEN + col0; c.ldw = NEVEN; c.nvalid = NEVEN - col0 < 128 ? (NEVEN - col0 < 0 ? 0 : NEVEN - col0) : 128; c.dst = (bf16_t*)(ws + WS_WT_EVEN_IN) + (size_t)nb * 128 * K + k0; } break;
    case 1: c.src = INP(19) + (size_t)k0 * D + nb * 128; c.ldw = D; c.dst = (bf16_t*)(ws + WS_WT_EVEN_OUT) + (size_t)nb * 128 * K + k0; break;
    case 2: case 3: { const int l = m - 2, pn = nb >> 1, half = nb & 1; c.src = INP(11) + (size_t)l * D * 2 * DFF + (size_t)k0 * 2 * DFF + half * DFF + pn * 128; c.ldw = 2 * DFF;
        c.dst = (bf16_t*)(ws + (l ? WS_WT_FFN_IN1 : WS_WT_FFN_IN0)) + (size_t)nb * 128 * K + k0; } break;
    case 4: case 5: { const int l = m - 4; c.src = INP(12) + (size_t)l * DFF * D + (size_t)k0 * D + nb * 128; c.ldw = D; c.dst = (bf16_t*)(ws + (l ? WS_WT_FFN_OUT1 : WS_WT_FFN_OUT0)) + (size_t)nb * 128 * K + k0; } break;
    case 6: c.src = INP(20) + (size_t)k0 * 4096 + nb * 128; c.ldw = 4096; c.dst = (bf16_t*)(ws + WS_WT_ODD_IN) + (size_t)nb * 128 * K + k0; break;
    case 7: { const int pn = nb >> 1, half = nb & 1, dir = pn >> 4, cg = pn & 15, ch0 = cg * 128, blk = ch0 >> 8, d0 = ch0 & 255;
        c.src = (half ? INP(25) : INP(23)) + (size_t)(dir * 8 + blk) * 256 * 256 + (size_t)k0 * 256 + d0; c.ldw = 256; c.dst = (bf16_t*)(ws + WS_WT_GATE) + (size_t)nb * 128 * K + k0; } break;
    default: c.src = INP(28) + (size_t)k0 * D + nb * 128; c.ldw = D; c.dst = (bf16_t*)(ws + WS_WT_ODD_OUT) + (size_t)nb * 128 * K + k0; break;
    }
    return c;
}
constexpr int NCONV_TILES = 3216;

constexpr int NCONV_L0 = 1360 + 352, NCONV_L1 = NCONV_TILES - NCONV_L0;
template <int LIST>
__device__ __forceinline__ int conv_map(int v) { return LIST == 0 ? (v < 1360 ? v : v + 704) : (v < 704 ? 1360 + v : 2416 + (v - 704)); }
template <int LIST>
__device__ __forceinline__ void convert_tiles(const Params& p, int wg, int nwg) {
    const int tid = threadIdx.x, n = tid & 127, kq = tid >> 7; constexpr int NT = LIST == 0 ? NCONV_L0 : NCONV_L1;
    const int per = (NT + nwg - 1) / nwg, vend = (wg + 1) * per < NT ? (wg + 1) * per : NT;
    for (int v = wg * per; v < vend; ++v) {
        const ConvTile c0 = conv_decode(p, conv_map<LIST>(v));
        float v0[64];
        const float* s0 = c0.src + (size_t)(kq * 64) * c0.ldw + n;
        const bool ok0 = n < c0.nvalid;
#pragma unroll
        for (int j = 0; j < 64; ++j) v0[j] = ok0 ? __builtin_nontemporal_load(s0 + (size_t)j * c0.ldw) : 0.f;
        bf16_t* dp = c0.dst + (size_t)n * c0.K + kq * 64;
#pragma unroll
        for (int q = 0; q < 8; ++q) *(u32x4*)(dp + q * 8) = (u32x4){cvt_pk_bf16(v0[8 * q], v0[8 * q + 1]), cvt_pk_bf16(v0[8 * q + 2], v0[8 * q + 3]), cvt_pk_bf16(v0[8 * q + 4], v0[8 * q + 5]), cvt_pk_bf16(v0[8 * q + 6], v0[8 * q + 7])};
    }
}

__device__ __forceinline__ void modulation_tasks(const Params& p, LAS unsigned char* lds, int l, int wg, int nwg) {
    const int tid = threadIdx.x;
    LAS float* lf = (LAS float*)lds;
    float* mod = (float*)(p.ws + WS_MOD);
    LAS float* sv = lf;
    LAS float* red = lf + 6144;
    const float* cctx = INP(6); const float* cvec = INP(5); const float* wmod = INP(9); const float* bmod = INP(10);
    for (int cb = wg; cb < 96; cb += nwg) {
        for (int i = tid; i < 6144; i += NTHREADS) { const int v = i >> 11, k = i & 2047; const float c = (v == 0) ? cctx[k] : cvec[(v - 1) * D + k]; sv[i] = c * sigm(c); }
        __syncthreads();
        const int j4 = tid & 31, kg = tid >> 5;
        const float* w = wmod + ((size_t)l * D + kg * 128) * 12288 + cb * 128 + j4 * 4;
        f32x4 a0 = {0.f, 0.f, 0.f, 0.f}, a1 = a0, a2 = a0;
#pragma unroll 8
        for (int k = 0; k < 128; ++k) { const f32x4 wv = __builtin_nontemporal_load((const f32x4*)(w + (size_t)k * 12288)); const int kk = kg * 128 + k; a0 += wv * sv[kk]; a1 += wv * sv[2048 + kk]; a2 += wv * sv[4096 + kk]; }
        LAS float* rr = red + (kg * 32 + j4) * 12;
#pragma unroll
        for (int e = 0; e < 4; ++e) { rr[e] = a0[e]; rr[4 + e] = a1[e]; rr[8 + e] = a2[e]; }
        __syncthreads();
        if (tid < 384) {
            const int q = tid % 12, jj = tid / 12, v = q >> 2, e = q & 3, col = cb * 128 + jj * 4 + e;
            float s2 = bmod[l * 12288 + col];
#pragma unroll
            for (int g2 = 0; g2 < 16; ++g2) s2 += red[(g2 * 32 + jj) * 12 + q];
            mod[(l * 3 + v) * 12288 + col] = s2;
        }
        __syncthreads();
    }
}

__device__ __forceinline__ void phase0(const Params& p, LAS unsigned char* lds) {
    const int tid = threadIdx.x, G = gridDim.x, b = blockIdx.x;
    LAS float* lf = (LAS float*)lds;
    if (b == G - 1) {
        const float* lp = INP(13); float* lb = (float*)(p.ws + WS_LB);
        for (int d = tid; d < 1024; d += NTHREADS) { const float a = lp[d], b1 = lp[1024 + d], c = lp[2048 + d]; const float mx = fmaxf(a, fmaxf(b1, c)); const float e0 = expf(a - mx), e1 = expf(b1 - mx), e2 = expf(c - mx); lb[d] = e0 / (e0 + e1 + e2); }
    }
    modulation_tasks(p, lds, 0, b, G);
    convert_tiles<0>(p, b, G);
}

__device__ __forceinline__ void phase_normmod(const float* x0, const float* x1, const float* g, const float* sh, const float* sc, bf16_t* hout) {
    const int lane = threadIdx.x & 63; const int gw = blockIdx.x * 8 + (threadIdx.x >> 6), nw = gridDim.x * 8;
    for (int rowa = gw; rowa < MTOK; rowa += 2 * nw) {
        const int rowb = rowa + nw; const bool hb = rowb < MTOK; const int rb = hb ? rowb : rowa;
        const float* xa = rowa < NPR ? x0 + (size_t)rowa * D : x1 + (size_t)(rowa - NPR) * D; const float* xb = rb < NPR ? x0 + (size_t)rb * D : x1 + (size_t)(rb - NPR) * D;
        const int va = row_cvec(rowa), vb = row_cvec(rb);
        f32x4 xv[8], yv[8]; float sa = 0.f, sb = 0.f;
#pragma unroll
        for (int i = 0; i < 8; ++i) { xv[i] = *(const f32x4*)(xa + (i * 64 + lane) * 4); yv[i] = *(const f32x4*)(xb + (i * 64 + lane) * 4); }
#pragma unroll
        for (int i = 0; i < 8; ++i) { sa += xv[i][0] * xv[i][0] + xv[i][1] * xv[i][1] + xv[i][2] * xv[i][2] + xv[i][3] * xv[i][3]; sb += yv[i][0] * yv[i][0] + yv[i][1] * yv[i][1] + yv[i][2] * yv[i][2] + yv[i][3] * yv[i][3]; }
        sa = wave_sum(sa); sb = wave_sum(sb); const float ra = rsqrtf(sa * (1.f / D) + 1e-6f), rbv = rsqrtf(sb * (1.f / D) + 1e-6f);
#pragma unroll
        for (int i = 0; i < 8; ++i) {
            const int c = (i * 64 + lane) * 4; const f32x4 gv = *(const f32x4*)(g + c);
            { const f32x4 sv = *(const f32x4*)(sc + va * 12288 + c), hv = *(const f32x4*)(sh + va * 12288 + c);
              const f32x4 o = xv[i] * ra * gv * (sv + 1.f) + hv; u32x2 w; w.x = cvt_pk_bf16(o[0], o[1]); w.y = cvt_pk_bf16(o[2], o[3]); *(u32x2*)(hout + (size_t)rowa * D + c) = w; }
            if (hb) { const f32x4 sv = *(const f32x4*)(sc + vb * 12288 + c), hv = *(const f32x4*)(sh + vb * 12288 + c);
              const f32x4 o = yv[i] * rbv * gv * (sv + 1.f) + hv; u32x2 w; w.x = cvt_pk_bf16(o[0], o[1]); w.y = cvt_pk_bf16(o[2], o[3]); *(u32x2*)(hout + (size_t)rowb * D + c) = w; }
        }
    }
}
__device__ __forceinline__ void phase_finalnorm(const float* x, const float* g, float* out) {
    const int lane = threadIdx.x & 63; const int gw = blockIdx.x * 8 + (threadIdx.x >> 6), nw = gridDim.x * 8;
    for (int rowa = gw; rowa < MTOK; rowa += 2 * nw) {
        const int rowb = rowa + nw; const bool hb = rowb < MTOK; const int rb = hb ? rowb : rowa;
        const float* xa = x + (size_t)rowa * D; const float* xb = x + (size_t)rb * D; f32x4 xv[8], yv[8]; float sa = 0.f, sb = 0.f;
#pragma unroll
        for (int i = 0; i < 8; ++i) { xv[i] = *(const f32x4*)(xa + (i * 64 + lane) * 4); yv[i] = *(const f32x4*)(xb + (i * 64 + lane) * 4); }
#pragma unroll
        for (int i = 0; i < 8; ++i) { sa += xv[i][0] * xv[i][0] + xv[i][1] * xv[i][1] + xv[i][2] * xv[i][2] + xv[i][3] * xv[i][3]; sb += yv[i][0] * yv[i][0] + yv[i][1] * yv[i][1] + yv[i][2] * yv[i][2] + yv[i][3] * yv[i][3]; }
        sa = wave_sum(sa); sb = wave_sum(sb); const float ra = rsqrtf(sa * (1.f / D) + 1e-6f), rbv = rsqrtf(sb * (1.f / D) + 1e-6f);
#pragma unroll
        for (int i = 0; i < 8; ++i) { const int c = (i * 64 + lane) * 4; const f32x4 gv = *(const f32x4*)(g + c);
            *(f32x4*)(out + (size_t)rowa * D + c) = xv[i] * ra * gv; if (hb) *(f32x4*)(out + (size_t)rowb * D + c) = yv[i] * rbv * gv; }
    }
}

constexpr size_t IMG_UNIT = 25088, IMG_VUNIT = 8192;
constexpr size_t WS_IMG_A = WS_HBUF, WS_IMG_B = WS_IMG_A + 4096 * IMG_UNIT, WS_IMG_V = WS_IMG_B + 2048 * IMG_UNIT, WS_IMG_END = WS_IMG_V + 4096 * IMG_VUNIT;
static_assert(WS_IMG_END <= WS_R, "operand images must fit in hbuf + xbuf + act");
constexpr int TOT_OFF = 0;
constexpr int BL_OFF = 2048;

__device__ __forceinline__ void phase_gateprep(const Params& p, LAS unsigned char* lds) {
    const int tid = threadIdx.x, hl = tid >> 7, d = tid & 127, G = gridDim.x;
    const bf16_t* Pb = (const bf16_t*)(p.ws + WS_PB); const float* Pg = (const float*)(p.ws + WS_PG); const float* Pl = (const float*)(p.ws + WS_PL);
    const float* wal = INP(15); const float* bal = INP(16);
    LAS float* BLs = (LAS float*)lds;
    for (int u = blockIdx.x; u < 1536; u += G) {
        const int kind = u >= 1024; const int uu = kind ? u - 1024 : u;
        const int hg = kind ? 0 : (uu & 1), dir = kind ? (uu & 1) : ((uu >> 1) & 1), sc = kind ? (uu >> 1) : (uu >> 2);
        const int head = hg * 4 + hl;
        const int qcol = kind ? 5120 + head * 128 : head * 128, kcol = 5632 + head * 128, gcol = dir * 1024 + head * 128;
        const size_t r0 = (size_t)sc * 32;
        float g[32]; unsigned qv[32], kv[32];
        if (kind) {
#pragma unroll
            for (int i = 0; i < 32; ++i) { qv[i] = Pb[(r0 + i) * 8192 + qcol + d]; kv[i] = Pb[(r0 + i) * 8192 + kcol + d]; }
            if (tid < 128) *(LAS f32x4*)(BLs + tid * 4) = *(const f32x4*)(Pl + (r0 + (tid >> 2)) * 32 + dir * 16 + (tid & 3) * 4);
            float wa[16];
#pragma unroll
            for (int r = 0; r < 16; ++r) wa[r] = wal[(dir * 16 + r) * 512 + head * 128 + d];
            const float ba = bal[dir * 512 + head * 128 + d];
            __syncthreads();
#pragma unroll
            for (int i = 0; i < 32; ++i) { float z = ba;
#pragma unroll
                for (int r4 = 0; r4 < 4; ++r4) { const f32x4 bv = *(const LAS f32x4*)(BLs + i * 16 + r4 * 4); z += bv[0] * wa[r4 * 4] + bv[1] * wa[r4 * 4 + 1] + bv[2] * wa[r4 * 4 + 2] + bv[3] * wa[r4 * 4 + 3]; }
                g[i] = (fminf(z, 0.f) - __logf(1.f + __expf(-fabsf(z)))) * 0.0625f; }
        } else {
#pragma unroll
            for (int i = 0; i < 32; ++i) { g[i] = Pg[(r0 + i) * 2048 + gcol + d]; qv[i] = Pb[(r0 + i) * 8192 + qcol + d]; }
        }
        unsigned char* img = p.ws + (kind ? WS_IMG_B : WS_IMG_A) + (size_t)(kind ? ((sc * 2 + dir) * 4 + head) : ((sc * 2 + dir) * 8 + head)) * IMG_UNIT;
        bf16_t* Qg = (bf16_t*)img; bf16_t* Kg = (bf16_t*)(img + 8192);
        float tot = 0.f;
#pragma unroll
        for (int i = 0; i < 32; ++i) tot += g[i];
        float run = 0.f; unsigned ktp[16] = {};
#pragma unroll
        for (int e = 0; e < 32; ++e) {
            const int i = dir ? 31 - e : e;
            run += g[i];
            const float kvf = kind ? __uint_as_float(kv[i] << 16) : 1.f - __expf(g[i]);
            const float qd = __uint_as_float(qv[i] << 16) * __expf(run), ki = kvf * __expf(-run), kt = kvf * __expf(tot - run);
            Qg[i * 128 + d] = (bf16_t)(cvt_pk_bf16(qd, 0.f) & 0xffffu); Kg[i * 128 + d] = (bf16_t)(cvt_pk_bf16(ki, 0.f) & 0xffffu);
            const unsigned kb = cvt_pk_bf16(kt, 0.f) & 0xffffu;
            if (i & 1) ktp[i >> 1] = (ktp[i >> 1] & 0xffffu) | (kb << 16); else ktp[i >> 1] = (ktp[i >> 1] & 0xffff0000u) | kb;
        }
#pragma unroll
        for (int q4 = 0; q4 < 4; ++q4) *(u32x4*)(img + 16384 + d * 64 + q4 * 16) = (u32x4){ktp[4 * q4], ktp[4 * q4 + 1], ktp[4 * q4 + 2], ktp[4 * q4 + 3]};
        *(float*)(img + 24576 + d * 4) = __expf(tot);
        if (dir == 0) {
            const int ns = kind ? 2 : 1;
            for (int sl = 0; sl < ns; ++sl) {
                const int vcol = kind ? 6144 + head * 256 + sl * 128 : 3072 + head * 128;
                unsigned vv[32];
#pragma unroll
                for (int i = 0; i < 32; ++i) vv[i] = Pb[(r0 + i) * 8192 + vcol + d];
                unsigned char* vimg = p.ws + WS_IMG_V + (size_t)(kind ? 2048 + (sc * 4 + head) * 2 + sl : sc * 8 + head) * IMG_VUNIT;
#pragma unroll
                for (int q4 = 0; q4 < 4; ++q4) *(u32x4*)(vimg + d * 64 + q4 * 16) = (u32x4){vv[8 * q4] | (vv[8 * q4 + 1] << 16), vv[8 * q4 + 2] | (vv[8 * q4 + 3] << 16), vv[8 * q4 + 4] | (vv[8 * q4 + 5] << 16), vv[8 * q4 + 6] | (vv[8 * q4 + 7] << 16)};
            }
        }
        if (kind) __syncthreads();
    }
}

constexpr int MB_QS = 0, MB_KS = 8704, MB_KT = 17408, MB_VT = 27648, MB_EB = 37888, MB_SIZE = 38400;
template <int KIND  >
__device__ __forceinline__ void mixer_item(const Params& p, LAS unsigned char* lds, int seq, int head, int dir, int slice) {
    const int tid = threadIdx.x, lane = tid & 63, w = tid >> 6, fr = lane & 15, fq = lane >> 4;
    bf16_t* Ob = (bf16_t*)(p.ws + (dir ? WS_OB : WS_OF));
    const int T = seq < 16 ? 256 : 2048, row0 = seq < 16 ? seq * 256 : NPR + (seq - 16) * 2048, nch = T / 32, sc0 = row0 / 32;
    const int ocol = KIND == 0 ? head * 128 : 1024 + head * 256 + slice * 128;
#define SD(dt, jj) (32 * ((dt) >> 1) + 8 * fq + 4 * ((dt) & 1) + (jj))
    f32x4 S[8];
    if (seq < 16) {
#pragma unroll
        for (int dt = 0; dt < 8; ++dt) S[dt] = (f32x4){0.f, 0.f, 0.f, 0.f};
    } else {
        const int bs = seq - 16;
        const float* s0 = KIND == 0 ? INP(2) + (size_t)((bs * 2 + dir) * 8 + head) * 128 * 128 : INP(3) + (size_t)((bs * 2 + dir) * 4 + head) * 128 * 256 + slice * 128;
        const int ld = KIND == 0 ? 128 : 256;
#pragma unroll
        for (int dt = 0; dt < 8; ++dt)
#pragma unroll
            for (int jj = 0; jj < 4; ++jj) S[dt][jj] = s0[(size_t)SD(dt, jj) * ld + 16 * w + fr];
    }
    const int lq = (tid >> 4) * 272 + (tid & 15) * 16;
    const int lk = (tid >> 2) * 80 + (tid & 3) * 16;
    const unsigned char* imgb = p.ws + (KIND ? WS_IMG_B : WS_IMG_A); const unsigned char* vimgb = p.ws + WS_IMG_V;
    u32x4 rq, rk, rt, rv, re;
#define MIX_SC(c) (sc0 + (dir ? nch - 1 - (c) : (c)))
#define MIX_LOAD(c) do { const int sc_ = MIX_SC(c); \
        const unsigned char* im_ = imgb + (size_t)(KIND ? ((sc_ * 2 + dir) * 4 + head) : ((sc_ * 2 + dir) * 8 + head)) * IMG_UNIT + tid * 16; \
        const unsigned char* vm_ = vimgb + (size_t)(KIND ? 2048 + (sc_ * 4 + head) * 2 + slice : sc_ * 8 + head) * IMG_VUNIT + tid * 16; \
        rq = __builtin_nontemporal_load((const u32x4*)im_); rk = __builtin_nontemporal_load((const u32x4*)(im_ + 8192)); rt = __builtin_nontemporal_load((const u32x4*)(im_ + 16384)); rv = __builtin_nontemporal_load((const u32x4*)vm_); \
        if (tid < 32) re = __builtin_nontemporal_load((const u32x4*)(im_ + 24576)); } while (0)
#define MIX_LAND() do { asm volatile("" : "+v"(rq)); asm volatile("" : "+v"(rk)); asm volatile("" : "+v"(rt)); asm volatile("" : "+v"(rv)); if (tid < 32) asm volatile("" : "+v"(re)); } while (0)
    MIX_LOAD(0); MIX_LAND();
    for (int c = 0; c < nch; ++c) {
      {
        LAS unsigned char* mb = lds + (c & 1) * MB_SIZE;
        *(LAS u32x4*)(mb + MB_QS + lq) = rq; *(LAS u32x4*)(mb + MB_KS + lq) = rk; *(LAS u32x4*)(mb + MB_KT + lk) = rt; *(LAS u32x4*)(mb + MB_VT + lk) = rv;
        if (tid < 32) *(LAS u32x4*)(mb + MB_EB + tid * 16) = re;
        __syncthreads();
        if (c + 1 < nch) MIX_LOAD(c + 1);
        __builtin_amdgcn_sched_barrier(0);
        LAS bf16_t* Qs = (LAS bf16_t*)(mb + MB_QS); LAS bf16_t* Ks = (LAS bf16_t*)(mb + MB_KS); LAS bf16_t* KTs = (LAS bf16_t*)(mb + MB_KT); LAS bf16_t* VTs = (LAS bf16_t*)(mb + MB_VT);
        LAS float* EBs = (LAS float*)(mb + MB_EB);
        f32x4 at00 = {0.f, 0.f, 0.f, 0.f}, atx = at00, at11 = at00;
        bf16x8 qf[2][4];
#pragma unroll
        for (int k4 = 0; k4 < 4; ++k4) {
            const bf16x8 k0 = *(const LAS bf16x8*)(Ks + fr * 136 + k4 * 32 + fq * 8), k1 = *(const LAS bf16x8*)(Ks + (16 + fr) * 136 + k4 * 32 + fq * 8);
            qf[0][k4] = *(const LAS bf16x8*)(Qs + fr * 136 + k4 * 32 + fq * 8); qf[1][k4] = *(const LAS bf16x8*)(Qs + (16 + fr) * 136 + k4 * 32 + fq * 8);
            at00 = __builtin_amdgcn_mfma_f32_16x16x32_bf16(k0, qf[0][k4], at00, 0, 0, 0);
            atx = __builtin_amdgcn_mfma_f32_16x16x32_bf16(dir ? k1 : k0, dir ? qf[0][k4] : qf[1][k4], atx, 0, 0, 0);
            at11 = __builtin_amdgcn_mfma_f32_16x16x32_bf16(k1, qf[1][k4], at11, 0, 0, 0);
        }
#pragma unroll
        for (int jj = 0; jj < 4; ++jj) { const bool keep = dir ? ((4 * fq + jj) >= fr) : ((4 * fq + jj) <= fr); at00[jj] = keep ? at00[jj] : 0.f; at11[jj] = keep ? at11[jj] : 0.f; }
        const unsigned x01 = cvt_pk_bf16(atx[0], atx[1]), x23 = cvt_pk_bf16(atx[2], atx[3]);
        u32x4 pa0, pa1;
        pa0.x = cvt_pk_bf16(at00[0], at00[1]); pa0.y = cvt_pk_bf16(at00[2], at00[3]); pa0.z = dir ? x01 : 0u; pa0.w = dir ? x23 : 0u;
        pa1.x = dir ? 0u : x01; pa1.y = dir ? 0u : x23; pa1.z = cvt_pk_bf16(at11[0], at11[1]); pa1.w = cvt_pk_bf16(at11[2], at11[3]);
        u32x4 sb[4];
#pragma unroll
        for (int k4 = 0; k4 < 4; ++k4) { sb[k4].x = cvt_pk_bf16(S[2 * k4][0], S[2 * k4][1]); sb[k4].y = cvt_pk_bf16(S[2 * k4][2], S[2 * k4][3]); sb[k4].z = cvt_pk_bf16(S[2 * k4 + 1][0], S[2 * k4 + 1][1]); sb[k4].w = cvt_pk_bf16(S[2 * k4 + 1][2], S[2 * k4 + 1][3]); }
        u32x4 vf; { const u32x2 lo = *(const LAS u32x2*)(VTs + (16 * w + fr) * 40 + 4 * fq), hi = *(const LAS u32x2*)(VTs + (16 * w + fr) * 40 + 16 + 4 * fq); vf = (u32x4){lo.x, lo.y, hi.x, hi.y}; }
        const size_t orow = (size_t)MIX_SC(c) * 32;
#pragma unroll
        for (int it = 0; it < 2; ++it) {
            f32x4 o = {0.f, 0.f, 0.f, 0.f};
#pragma unroll
            for (int k4 = 0; k4 < 4; ++k4) o = __builtin_amdgcn_mfma_f32_16x16x32_bf16(__builtin_bit_cast(bf16x8, sb[k4]), qf[it][k4], o, 0, 0, 0);
            o = __builtin_amdgcn_mfma_f32_16x16x32_bf16(__builtin_bit_cast(bf16x8, vf), __builtin_bit_cast(bf16x8, it ? pa1 : pa0), o, 0, 0, 0);
            u32x2 ow; ow.x = cvt_pk_bf16(o[0], o[1]); ow.y = cvt_pk_bf16(o[2], o[3]);
            *(u32x2*)(Ob + (orow + 16 * it + fr) * D + ocol + 16 * w + 4 * fq) = ow;
        }
        const bf16x8 vb = *(const LAS bf16x8*)(VTs + (16 * w + fr) * 40 + fq * 8);
#pragma unroll
        for (int dt = 0; dt < 8; ++dt) {
            const f32x4 eb = *(const LAS f32x4*)(EBs + 32 * (dt >> 1) + 8 * fq + 4 * (dt & 1));
            const bf16x8 ka = *(const LAS bf16x8*)(KTs + (32 * (dt >> 1) + 8 * (fr >> 2) + 4 * (dt & 1) + (fr & 3)) * 40 + fq * 8);
            S[dt] = __builtin_amdgcn_mfma_f32_16x16x32_bf16(ka, vb, S[dt] * eb, 0, 0, 0);
        }
        __builtin_amdgcn_sched_barrier(0);
        MIX_LAND();
      }
    }
    __syncthreads();
#undef MIX_LAND
#undef MIX_LOAD
#undef MIX_SC
    if (seq < 16) {
        float* so = KIND == 0 ? p.out + OUT_H + (size_t)((seq * 2 + dir) * 8 + head) * 128 * 128 : p.out + OUT_G + (size_t)((seq * 2 + dir) * 4 + head) * 128 * 256 + slice * 128;
        const int ld = KIND == 0 ? 128 : 256;
#pragma unroll
        for (int dt = 0; dt < 8; ++dt)
#pragma unroll
            for (int jj = 0; jj < 4; ++jj) __builtin_nontemporal_store(S[dt][jj], so + (size_t)SD(dt, jj) * ld + 16 * w + fr);
    }
}
#undef SD
#ifndef MIXK
#define MIXK 2
#endif
__device__ __forceinline__ void phase_mixer(const Params& p, LAS unsigned char* lds) {
    const int G = gridDim.x, b = blockIdx.x;
    int it = b;
    const int step = (G >= 128) ? (b < 64 ? 100000 : G - 64) : G;
    for (; it < 576; it += step) {
        const int is_long = it < 64, idx = is_long ? it : it - 64;
        const int per = is_long ? 32 : 256; const int kind = idx / per, r = idx % per; const int seq = (is_long ? 16 : 0) + r / 16, rem = r % 16;
        if (kind == 0) { if (MIXK != 1) mixer_item<0>(p, lds, seq, rem >> 1, rem & 1, 0); }
        else { if (MIXK != 0) mixer_item<1>(p, lds, seq, rem >> 2, (rem >> 1) & 1, rem & 1); }
    }
    if (G >= 128) { if (b >= 64) convert_tiles<1>(p, b - 64, G - 64); }
    else convert_tiles<1>(p, b, G);
}

__device__ __forceinline__ void phase_combine(const Params& p) {
    const int lane = threadIdx.x & 63; const int gw = blockIdx.x * 8 + (threadIdx.x >> 6), nw = gridDim.x * 8;
    const float* gainA = INP(17); const float* gainB = INP(18);
    const bf16_t* Of = (const bf16_t*)(p.ws + WS_OF); const bf16_t* Obw = (const bf16_t*)(p.ws + WS_OB); const bf16_t* Pb = (const bf16_t*)(p.ws + WS_PB); bf16_t* mg = (bf16_t*)(p.ws + WS_HBUF);
    for (int row = gw; row < MTOK; row += nw) {
#pragma unroll
        for (int i = 0; i < 8; ++i) {
            const int c = i * 256 + lane * 4;
            const u32x2 of2 = *(const u32x2*)(Of + (size_t)row * D + c), ob2 = *(const u32x2*)(Obw + (size_t)row * D + c);
            const f32x4 o = {__uint_as_float(of2.x << 16) + __uint_as_float(ob2.x << 16), __uint_as_float(of2.x & 0xffff0000u) + __uint_as_float(ob2.x & 0xffff0000u),
                             __uint_as_float(of2.y << 16) + __uint_as_float(ob2.y << 16), __uint_as_float(of2.y & 0xffff0000u) + __uint_as_float(ob2.y & 0xffff0000u)};
            float ss = o[0] * o[0] + o[1] * o[1] + o[2] * o[2] + o[3] * o[3];
            ss += __shfl_xor(ss, 1); ss += __shfl_xor(ss, 2); ss += __shfl_xor(ss, 4); ss += __shfl_xor(ss, 8); ss += __shfl_xor(ss, 16);
            float rinv; f32x4 gn; int gcol;
            if (i < 4) { rinv = rsqrtf(ss * (1.f / 128.f) + 1e-6f); gn = *(const f32x4*)(gainA + (c & 127)); gcol = 4096 + c; }
            else { ss += __shfl_xor(ss, 32); rinv = rsqrtf(ss * (1.f / 256.f) + 1e-6f); gn = *(const f32x4*)(gainB + (c & 255)); gcol = 7168 + (c - 1024); }
            const u32x2 gw2 = *(const u32x2*)(Pb + (size_t)row * 8192 + gcol);
            const float g0 = __uint_as_float(gw2.x << 16), g1 = __uint_as_float(gw2.x & 0xffff0000u), g2 = __uint_as_float(gw2.y << 16), g3 = __uint_as_float(gw2.y & 0xffff0000u);
            const f32x4 r = o * rinv * gn; u32x2 wv;
            wv.x = cvt_pk_bf16(r[0] * g0 * sigm(g0), r[1] * g1 * sigm(g1)); wv.y = cvt_pk_bf16(r[2] * g2 * sigm(g2), r[3] * g3 * sigm(g3));
            *(u32x2*)(mg + (size_t)row * D + c) = wv;
        }
    }
}

__device__ __forceinline__ void phase_conv(const Params& p) {
    const bf16_t* xr = (const bf16_t*)(p.ws + WS_XR); bf16_t* xcb = (bf16_t*)(p.ws + WS_XCB);
    const float* cw = INP(21); const float* cb = INP(22);
    const int nthr = gridDim.x * NTHREADS;
    for (int idx = blockIdx.x * NTHREADS + threadIdx.x; idx < (MTOK / 4) * 256; idx += nthr) {
        const int r0 = (idx >> 8) * 4, c = (idx & 255) * 8; const int L = r0 < NPR ? 256 : 64, pos = r0 & (L - 1);
        u32x4 xin[7];
#pragma unroll
        for (int t = 0; t < 7; ++t) { const int q = pos + t - 2; xin[t] = (q >= 0 && q < L) ? *(const u32x4*)(xr + (size_t)(r0 + t - 2) * D + c) : (u32x4){0u, 0u, 0u, 0u}; }
        f32x4 wlo[4], whi[4];
#pragma unroll
        for (int j = 0; j < 4; ++j) { wlo[j] = *(const f32x4*)(cw + j * D + c); whi[j] = *(const f32x4*)(cw + j * D + c + 4); }
        const f32x4 blo = *(const f32x4*)(cb + c), bhi = *(const f32x4*)(cb + c + 4);
#pragma unroll
        for (int o = 0; o < 4; ++o) {
            f32x4 alo = blo, ahi = bhi;
#pragma unroll
            for (int j = 0; j < 4; ++j) {
                const u32x4 xw = xin[o + j];
                const f32x4 xl = {__uint_as_float(xw.x << 16), __uint_as_float(xw.x & 0xffff0000u), __uint_as_float(xw.y << 16), __uint_as_float(xw.y & 0xffff0000u)};
                const f32x4 xh = {__uint_as_float(xw.z << 16), __uint_as_float(xw.z & 0xffff0000u), __uint_as_float(xw.w << 16), __uint_as_float(xw.w & 0xffff0000u)};
                alo += xl * wlo[j]; ahi += xh * whi[j];
            }
            *(u32x4*)(xcb + (size_t)(r0 + o) * D + c) = (u32x4){cvt_pk_bf16(alo[0], alo[1]), cvt_pk_bf16(alo[2], alo[3]), cvt_pk_bf16(ahi[0], ahi[1]), cvt_pk_bf16(ahi[2], ahi[3])};
        }
    }
}

__device__ __forceinline__ void scan_item(const Params& p, LAS unsigned char* lds, int seq, int cbk) {
    constexpr int SB = 16;
    const int tid = threadIdx.x, ch = cbk * 32 + (tid & 31), seg = tid >> 5;
    const int T = seq < 16 ? 256 : 2048, row0 = seq < 16 ? seq * 256 : NPR + (seq - 16) * 2048, sl = T / 16;
    const unsigned* const AU0 = (const unsigned*)(p.ws + WS_XR); const unsigned* const AU1 = (const unsigned*)(p.ws + WS_UF);
    bf16_t* YF = (bf16_t*)(p.ws + WS_ACT); const bf16_t* gg = (const bf16_t*)(p.ws + WS_GG); bf16_t* y = (bf16_t*)(p.ws + WS_HBUF);
    LAS float* PH = (LAS float*)lds;
    const int t0 = seg * sl;
#define SC_U(w) __uint_as_float((w) << 16)
#define SC_A(w) (1.f - __uint_as_float((w) & 0xffff0000u))
#pragma unroll
    for (int dir = 0; dir < 2; ++dir) {
        const unsigned* AU = (dir ? AU1 : AU0) + (size_t)row0 * D + ch;
        float P = 1.f, H = 0.f; unsigned wv[SB];
#pragma unroll
        for (int e = 0; e < SB; ++e) { const int tok = dir ? t0 + sl - 1 - e : t0 + e; wv[e] = AU[(size_t)tok * D]; }
        for (int s = 0; s < sl; s += SB) {
            unsigned wn[SB];
            if (s + SB < sl) {
#pragma unroll
                for (int e = 0; e < SB; ++e) { const int tok = dir ? t0 + sl - 1 - (s + SB + e) : t0 + s + SB + e; wn[e] = AU[(size_t)tok * D]; }
            }
#pragma unroll
            for (int e = 0; e < SB; ++e) { const float a = SC_A(wv[e]); H = a * H + SC_U(wv[e]); P *= a; }
#pragma unroll
            for (int e = 0; e < SB; ++e) wv[e] = wn[e];
        }
        PH[((dir * 16 + seg) * 32 + (tid & 31)) * 2] = P; PH[((dir * 16 + seg) * 32 + (tid & 31)) * 2 + 1] = H;
    }
    __syncthreads();
    float carry[2];
#pragma unroll
    for (int dir = 0; dir < 2; ++dir) {
        float h = seq < 16 ? 0.f : INP(4)[(size_t)((seq - 16) * 2 + dir) * D + ch];
        for (int k = 0; k < 16; ++k) { const int s2 = dir ? 15 - k : k; const bool pre = dir ? (s2 > seg) : (s2 < seg);
            const float P = PH[((dir * 16 + s2) * 32 + (tid & 31)) * 2], H = PH[((dir * 16 + s2) * 32 + (tid & 31)) * 2 + 1]; if (pre) h = P * h + H; }
        carry[dir] = h;
    }
    {
        const unsigned* AU = AU0 + (size_t)row0 * D + ch; bf16_t* Y = YF + (size_t)row0 * D + ch; float h = carry[0];
        unsigned wv[SB];
#pragma unroll
        for (int e = 0; e < SB; ++e) wv[e] = AU[(size_t)(t0 + e) * D];
        for (int s = 0; s < sl; s += SB) {
            unsigned wn[SB];
            if (s + SB < sl) {
#pragma unroll
                for (int e = 0; e < SB; ++e) wn[e] = AU[(size_t)(t0 + s + SB + e) * D];
            }
#pragma unroll
            for (int e = 0; e < SB; ++e) { h = SC_A(wv[e]) * h + SC_U(wv[e]); Y[(size_t)(t0 + s + e) * D] = (bf16_t)(cvt_pk_bf16(h, 0.f) & 0xffffu); }
#pragma unroll
            for (int e = 0; e < SB; ++e) wv[e] = wn[e];
        }
        if (seq < 16 && seg == 15) p.out[OUT_R + (size_t)(seq * 2 + 0) * D + ch] = h;
    }
    __syncthreads();
    {
        const unsigned* AU = AU1 + (size_t)row0 * D + ch; const bf16_t* Y = YF + (size_t)row0 * D + ch;
        const bf16_t* Gp = gg + (size_t)row0 * D + ch; bf16_t* yo = y + (size_t)row0 * D + ch; float h = carry[1];
        unsigned wv[8]; unsigned yf[8]; unsigned gv[8];
#pragma unroll
        for (int e = 0; e < 8; ++e) { const int tok = t0 + sl - 1 - e; wv[e] = AU[(size_t)tok * D]; yf[e] = Y[(size_t)tok * D]; gv[e] = Gp[(size_t)tok * D]; }
        for (int s = 0; s < sl; s += 8) {
            unsigned wn[8]; unsigned yn[8]; unsigned gn[8];
            if (s + 8 < sl) {
#pragma unroll
                for (int e = 0; e < 8; ++e) { const int tok = t0 + sl - 1 - (s + 8 + e); wn[e] = AU[(size_t)tok * D]; yn[e] = Y[(size_t)tok * D]; gn[e] = Gp[(size_t)tok * D]; }
            }
#pragma unroll
            for (int e = 0; e < 8; ++e) { const int tok = t0 + sl - 1 - (s + e); h = SC_A(wv[e]) * h + SC_U(wv[e]); yo[(size_t)tok * D] = (bf16_t)(cvt_pk_bf16((__uint_as_float(yf[e] << 16) + h) * __uint_as_float(gv[e] << 16), 0.f) & 0xffffu); }
#pragma unroll
            for (int e = 0; e < 8; ++e) { wv[e] = wn[e]; yf[e] = yn[e]; gv[e] = gn[e]; }
        }
        if (seq < 16 && seg == 0) p.out[OUT_R + (size_t)(seq * 2 + 1) * D + ch] = h;
    }
    __syncthreads();
#undef SC_U
#undef SC_A
}
__device__ __forceinline__ void phase_scan(const Params& p, LAS unsigned char* lds) {
    const int G = gridDim.x, b = blockIdx.x;
    int it = b; const int step = (G >= 256) ? (b < 128 ? 100000 : G - 128) : G;
    for (; it < 1152; it += step) {
        const int seq = it < 128 ? 16 + (it >> 6) : (it - 128) >> 6, cbk = it < 128 ? (it & 63) : ((it - 128) & 63);
        scan_item(p, lds, seq, cbk);
    }
}

__device__ __forceinline__ void blr_minigemm(const bf16_t* h, const bf16_t* wt, float* Pl, LAS unsigned char* lds) {
    const int tid = threadIdx.x, lane = tid & 63, w = tid >> 6, fr = lane & 15, fq = lane >> 4;
    LAS float* red = (LAS float*)lds;
    for (int rb = blockIdx.x; rb < MTOK / 32; rb += gridDim.x) {
        const int row0 = rb * 32;
        f32x4 a00 = {0.f, 0.f, 0.f, 0.f}, a01 = a00, a10 = a00, a11 = a00;
#pragma unroll
        for (int ks = 0; ks < 8; ++ks) {
            const int k0 = (w * 8 + ks) * 32 + fq * 8;
            const bf16x8 h0 = *(const bf16x8*)(h + (size_t)(row0 + fr) * D + k0), h1 = *(const bf16x8*)(h + (size_t)(row0 + 16 + fr) * D + k0);
            const bf16x8 w0 = *(const bf16x8*)(wt + (size_t)fr * D + k0), w1 = *(const bf16x8*)(wt + (size_t)(16 + fr) * D + k0);
            a00 = __builtin_amdgcn_mfma_f32_16x16x32_bf16(h0, w0, a00, 0, 0, 0); a01 = __builtin_amdgcn_mfma_f32_16x16x32_bf16(h0, w1, a01, 0, 0, 0);
            a10 = __builtin_amdgcn_mfma_f32_16x16x32_bf16(h1, w0, a10, 0, 0, 0); a11 = __builtin_amdgcn_mfma_f32_16x16x32_bf16(h1, w1, a11, 0, 0, 0);
        }
        *(LAS f32x4*)(red + ((w * 4 + 0) * 64 + lane) * 4) = a00; *(LAS f32x4*)(red + ((w * 4 + 1) * 64 + lane) * 4) = a01;
        *(LAS f32x4*)(red + ((w * 4 + 2) * 64 + lane) * 4) = a10; *(LAS f32x4*)(red + ((w * 4 + 3) * 64 + lane) * 4) = a11;
        __syncthreads();
        if (tid < 256) {
            const int tile = tid >> 6, l = tid & 63, mt = tile >> 1, nt = tile & 1;
            f32x4 sacc = {0.f, 0.f, 0.f, 0.f};
#pragma unroll
            for (int ww = 0; ww < 8; ++ww) sacc += *(const LAS f32x4*)(red + ((ww * 4 + tile) * 64 + l) * 4);
#pragma unroll
            for (int jj = 0; jj < 4; ++jj) Pl[(size_t)(row0 + 16 * mt + 4 * (l >> 4) + jj) * 32 + 16 * nt + (l & 15)] = sacc[jj];
        }
        __syncthreads();
    }
}

#define XB_TMO      128
#define XB_XCNT(j)  (256  + 64 * (j))
#define XB_XSUB(j)  (1280 + 64 * (j))
#define XB_XGEN(j)  (2304 + 64 * (j))
#define XB_TOP      3328
#define XB_TOPGEN   3392
#define XCD_BAR_WORDS 3456
#define XB_SPIN_CAP (1u << 18)
static_assert(XCD_BAR_WORDS * 4 <= SZ_BAR, "barrier words");
__device__ __forceinline__ unsigned xb_ld(unsigned* p)              { return __hip_atomic_load(p, __ATOMIC_RELAXED, __HIP_MEMORY_SCOPE_AGENT); }
__device__ __forceinline__ unsigned xb_add(unsigned* p, unsigned v) { return __hip_atomic_fetch_add(p, v, __ATOMIC_RELAXED, __HIP_MEMORY_SCOPE_AGENT); }
__device__ __forceinline__ unsigned xb_xcc_id() { return (unsigned)__builtin_amdgcn_s_getreg((3 << 11) | 20) & 0xFu; }
#define XB_SPIN(cond, bar) do { unsigned _sp = 0; while (cond) { __builtin_amdgcn_s_sleep(1); \
    if ((++_sp & 255u) == 0u) { if (xb_ld(&(bar)[XB_TMO])) break; if (_sp > XB_SPIN_CAP) { atomicAdd(&(bar)[XB_TMO], 1u); break; } } } } while (0)
struct XcdBarrier { unsigned* bar; unsigned x; volatile LAS unsigned* st; };
__device__ __forceinline__ XcdBarrier xcd_barrier_post(unsigned* bar, volatile LAS unsigned* st) {
    XcdBarrier b; b.bar = bar; b.x = xb_xcc_id(); b.st = st;
    if (threadIdx.x == 0) (void)xb_add(&bar[XB_XCNT(b.x)], 1u);
    return b;
}
__device__ __forceinline__ void xcd_barrier_complete(unsigned* bar, unsigned x, unsigned& nloc, unsigned& nx) {
    const unsigned G = gridDim.x * gridDim.y * gridDim.z;
    unsigned sum, cnt, mine, sp = 0u;
    for (;;) {
        sum = 0u; cnt = 0u; mine = 0u;
#pragma unroll
        for (unsigned j = 0; j < 16; ++j) { const unsigned c = xb_ld(&bar[XB_XCNT(j)]); sum += c; cnt += (c > 0u) ? 1u : 0u; mine = (j == x) ? c : mine; }
        if (sum == G) break;
        __builtin_amdgcn_s_sleep(1);
        if ((++sp & 255u) == 0u) { if (xb_ld(&bar[XB_TMO])) break; if (sp > XB_SPIN_CAP) { atomicAdd(&bar[XB_TMO], 1u); break; } }
    }
    nloc = mine > 0u ? mine : 1u; nx = cnt > 0u ? cnt : 1u;
}
__device__ __forceinline__ void xcd_barrier(const XcdBarrier& b) {
    asm volatile("s_waitcnt vmcnt(0)" ::: "memory");
    __syncthreads();
    if (threadIdx.x == 0) {
        unsigned* bar = b.bar;
        __builtin_amdgcn_s_waitcnt(0);
        unsigned nloc = b.st[0], nx = b.st[1];
        if (nloc == 0u) { xcd_barrier_complete(bar, b.x, nloc, nx); b.st[0] = nloc; b.st[1] = nx; }
        const unsigned old = xb_add(&bar[XB_XSUB(b.x)], 1u);
        const unsigned gen = old / nloc;
        if (old + 1u == (gen + 1u) * nloc) {
            __builtin_amdgcn_fence(__ATOMIC_RELEASE, "agent");
            asm volatile("s_waitcnt vmcnt(0)" ::: "memory");
            const unsigned og = xb_add(&bar[XB_TOP], 1u);
            const unsigned tg = og / nx;
            if (og + 1u == (tg + 1u) * nx) xb_add(&bar[XB_TOPGEN], 1u);
            else XB_SPIN(xb_ld(&bar[XB_TOPGEN]) == tg, bar);
            __builtin_amdgcn_fence(__ATOMIC_ACQUIRE, "agent");
            xb_add(&bar[XB_XGEN(b.x)], 1u);
            asm volatile("s_waitcnt vmcnt(0)" ::: "memory");
        } else {
            XB_SPIN(xb_ld(&bar[XB_XGEN(b.x)]) == gen, bar);
            __builtin_amdgcn_fence(__ATOMIC_ACQUIRE, "agent");
            asm volatile("s_waitcnt vmcnt(0)" ::: "memory");
        }
    }
    __syncthreads();
}

__global__ void __launch_bounds__(NTHREADS, 2) mega_fwd(Params p) {
    extern __shared__ __attribute__((aligned(16))) unsigned char lds_raw[];
    LAS unsigned char* lds = (LAS unsigned char*)lds_raw;
    cg::grid_group grid = cg::this_grid();
    unsigned char* ws = p.ws;
    const float* mod = (const float*)(ws + WS_MOD);
    bf16_t* hbuf = (bf16_t*)(ws + WS_HBUF); float* xbuf = (float*)(ws + WS_XBUF); bf16_t* act = (bf16_t*)(ws + WS_ACT);
    const int G = gridDim.x, bid = blockIdx.x;
    const int lo = p.ph_lo, hi = p.ph_hi;
    if (lo < 0) grid.sync();
    XcdBarrier xbar; xbar.bar = (unsigned*)(ws + WS_BAR); xbar.x = 0; xbar.st = (volatile LAS unsigned*)(lds + 131072);
    if (hi - lo > 1) {
        if (threadIdx.x < 4) ((LAS unsigned*)(lds + 131072))[threadIdx.x] = 0u;
        __syncthreads();
        xbar = xcd_barrier_post((unsigned*)(ws + WS_BAR), (volatile LAS unsigned*)(lds + 131072));
    }
#define FUSEDN(k) ((k) == 7 || (k) == 10 || (k) == 16 || (k) == 19)
#define IN(k) (EN(k) && !FUSEDN(k) && lo <= (k) && (k) < hi)
#define SEAM(k) do { if ((k) + 1 < hi) xcd_barrier(xbar); } while (0)
    if (IN(0)) {
#if EN(0)
        phase0(p, lds);
#endif
        SEAM(0);
    }
    if (IN(1)) {
#if EN(1)
        phase_normmod(INP(0), INP(1), INP(7), mod + 0 * 2048, mod + 1 * 2048, hbuf);
#endif
        SEAM(1);
    }
    if (IN(2)) {
#if EN(2)
        blr_minigemm(hbuf, (const bf16_t*)(ws + WS_WT_EVEN_IN) + (size_t)8192 * D, (float*)(ws + WS_PL), lds);
        { pg8::Gemm g{hbuf, (const bf16_t*)(ws + WS_WT_EVEN_IN), MTOK, 8192, D, D, 0}; pg8::StaticOrder S; S.init(MTOK, 8192, G, bid);
            EpiEvenIn E{(bf16_t*)(ws + WS_PB), (float*)(ws + WS_PG), (float*)(ws + WS_PL), (const float*)(ws + WS_LB)}; pg8::gemm_phase(lds, g, S, E); }
#endif
        SEAM(2);
    }
    if (IN(3)) {
#if EN(3)
        phase_gateprep(p, lds);
#endif
        SEAM(3);
    }
    if (IN(4)) {
#if EN(4)
        phase_mixer(p, lds);
#endif
        SEAM(4);
    }
    if (IN(5)) {
#if EN(5)
        phase_combine(p);
#endif
        SEAM(5);
    }
    if (IN(6)) {
#if EN(6)
        { pg8::Gemm g{hbuf, (const bf16_t*)(ws + WS_WT_EVEN_OUT), MTOK, D, D, D, 0}; pg8::StaticOrder S; S.init(MTOK, D, G, bid);
            EpiResidNorm E{INP(0), INP(1), xbuf, mod + 2 * 2048, (float*)(ws + WS_NS + SZ_NS_CNT) + (size_t)0 * 8192 * 8, (unsigned*)(ws + WS_NS) + 0 * 2048, INP(8), mod + 3 * 2048, mod + 4 * 2048, hbuf, nullptr, lds, 1}; pg8::gemm_phase(lds, g, S, E); }
#endif
        SEAM(6);
    }
    if (IN(7)) {
#if EN(7)
        phase_normmod(xbuf, xbuf + (size_t)NPR * D, INP(8), mod + 3 * 2048, mod + 4 * 2048, hbuf);
#endif
        SEAM(7);
    }
    if (IN(8)) {
#if EN(8)
        { pg8::Gemm g{hbuf, (const bf16_t*)(ws + WS_WT_FFN_IN0), MTOK, 2 * DFF, D, D, 0}; pg8::StaticOrder S; S.init(MTOK, 2 * DFF, G, bid);
            EpiSwiglu E{act}; pg8::gemm_phase(lds, g, S, E); }
        if (G == 256) { if (bid >= 128) modulation_tasks(p, lds, 1, bid - 128, 128); }
        else modulation_tasks(p, lds, 1, bid, G);
#endif
        SEAM(8);
    }
    if (IN(9)) {
#if EN(9)
        { pg8::Gemm g{act, (const bf16_t*)(ws + WS_WT_FFN_OUT0), MTOK, D, DFF, DFF, 0}; pg8::StaticOrder S; S.init(MTOK, D, G, bid);
            EpiResidNorm E{xbuf, xbuf + (size_t)NPR * D, xbuf, mod + 5 * 2048, (float*)(ws + WS_NS + SZ_NS_CNT) + (size_t)1 * 8192 * 8, (unsigned*)(ws + WS_NS) + 1 * 2048, INP(7) + D, mod + 3 * 12288 + 0 * 2048, mod + 3 * 12288 + 1 * 2048, hbuf, nullptr, lds, 1}; pg8::gemm_phase(lds, g, S, E); }
#endif
        SEAM(9);
    }
    if (IN(10)) {
#if EN(10)
        phase_normmod(xbuf, xbuf + (size_t)NPR * D, INP(7) + D, mod + 3 * 12288 + 0 * 2048, mod + 3 * 12288 + 1 * 2048, hbuf);
#endif
        SEAM(10);
    }
    if (IN(11)) {
#if EN(11)
        { pg8::Gemm g{hbuf, (const bf16_t*)(ws + WS_WT_ODD_IN), MTOK, 4096, D, D, 0}; pg8::StaticOrder S; S.init(MTOK, 4096, G, bid);
            EpiOddIn E{(bf16_t*)(ws + WS_XR), (bf16_t*)(ws + WS_GG)}; pg8::gemm_phase(lds, g, S, E); }
#endif
        SEAM(11);
    }
    if (IN(12)) {
#if EN(12)
        phase_conv(p);
#endif
        SEAM(12);
    }
    if (IN(13)) {
#if EN(13)
        { pg8::Gemm g{(const bf16_t*)(ws + WS_XCB), (const bf16_t*)(ws + WS_WT_GATE), MTOK, 8192, 256, D, 1}; pg8::StaticOrder S; S.init(MTOK, 8192, G, bid);
            EpiGate E{(const bf16_t*)(ws + WS_XCB), INP(24), INP(26), INP(27), (unsigned*)(ws + WS_XR), (unsigned*)(ws + WS_UF)}; pg8::gemm_phase(lds, g, S, E); }
#endif
        SEAM(13);
    }
    if (IN(14)) {
#if EN(14)
        phase_scan(p, lds);
#endif
        SEAM(14);
    }
    if (IN(15)) {
#if EN(15)
        { pg8::Gemm g{hbuf, (const bf16_t*)(ws + WS_WT_ODD_OUT), MTOK, D, D, D, 0}; pg8::StaticOrder S; S.init(MTOK, D, G, bid);
            EpiResidNorm E{xbuf, xbuf + (size_t)NPR * D, xbuf, mod + 3 * 12288 + 2 * 2048, (float*)(ws + WS_NS + SZ_NS_CNT) + (size_t)2 * 8192 * 8, (unsigned*)(ws + WS_NS) + 2 * 2048, INP(8) + D, mod + 3 * 12288 + 3 * 2048, mod + 3 * 12288 + 4 * 2048, hbuf, nullptr, lds, 1}; pg8::gemm_phase(lds, g, S, E); }
#endif
        SEAM(15);
    }
    if (IN(16)) {
#if EN(16)
        phase_normmod(xbuf, xbuf + (size_t)NPR * D, INP(8) + D, mod + 3 * 12288 + 3 * 2048, mod + 3 * 12288 + 4 * 2048, hbuf);
#endif
        SEAM(16);
    }
    if (IN(17)) {
#if EN(17)
        { pg8::Gemm g{hbuf, (const bf16_t*)(ws + WS_WT_FFN_IN1), MTOK, 2 * DFF, D, D, 0}; pg8::StaticOrder S; S.init(MTOK, 2 * DFF, G, bid);
            EpiSwiglu E{act}; pg8::gemm_phase(lds, g, S, E); }
#endif
        SEAM(17);
    }
    if (IN(18)) {
#if EN(18)
        { pg8::Gemm g{act, (const bf16_t*)(ws + WS_WT_FFN_OUT1), MTOK, D, DFF, DFF, 0}; pg8::StaticOrder S; S.init(MTOK, D, G, bid);
            EpiResidNorm E{xbuf, xbuf + (size_t)NPR * D, xbuf, mod + 3 * 12288 + 5 * 2048, (float*)(ws + WS_NS + SZ_NS_CNT) + (size_t)3 * 8192 * 8, (unsigned*)(ws + WS_NS) + 3 * 2048, INP(29), nullptr, nullptr, nullptr, p.out + OUT_Y, lds, hi > 1000}; pg8::gemm_phase(lds, g, S, E); }
#endif
        SEAM(18);
    }
    if (IN(19)) {
#if EN(19)
        phase_finalnorm(xbuf, INP(29), p.out + OUT_Y);
#endif
        SEAM(19);
    }
#ifdef DBG_STOP
#ifndef DBG_OFF
#define DBG_OFF 0
#endif
#ifndef DBG_STRIDE
#define DBG_STRIDE 1
#endif
    if (lo == 99) {
        const unsigned* src = (const unsigned*)(ws + (size_t)DBG_OFF);
        const size_t nout = (size_t)MTOK * D + 2 * 4194304 + 65536;
        for (size_t j = (size_t)blockIdx.x * NTHREADS + threadIdx.x; j < nout / 2; j += (size_t)gridDim.x * NTHREADS) { const unsigned w = (j * DBG_STRIDE < (size_t)DBG_NW) ? src[j * DBG_STRIDE] : 0u; p.out[2 * j] = (float)(w & 0xffffu); p.out[2 * j + 1] = (float)(w >> 16); }
    }
#endif
#undef IN
#undef SEAM
}

extern "C" void kernel_launch(void* const* d_in, const int* in_sizes, int n_in, void* d_out, int out_size, void* d_ws, size_t ws_size, hipStream_t stream) {
    static int grid = 0;
    if (grid == 0) {
        if (n_in != 30 || ws_size < WS_END) { fprintf(stderr, "kernel_launch: need 30 inputs and >= %zu bytes of workspace (got %d, %zu)\n", (size_t)WS_END, n_in, ws_size); grid = -1; return; }
        int dev = 0, cus = 0, per_cu = 0;
        if (hipGetDevice(&dev) != hipSuccess || hipDeviceGetAttribute(&cus, hipDeviceAttributeMultiprocessorCount, dev) != hipSuccess) { fprintf(stderr, "kernel_launch: device query failed\n"); grid = -1; return; }
        if (hipFuncSetAttribute((const void*)mega_fwd, hipFuncAttributeMaxDynamicSharedMemorySize, LDS_BYTES) != hipSuccess) { fprintf(stderr, "kernel_launch: hipFuncSetAttribute failed\n"); grid = -1; return; }
        if (hipOccupancyMaxActiveBlocksPerMultiprocessor(&per_cu, (const void*)mega_fwd, NTHREADS, LDS_BYTES) != hipSuccess || per_cu < 1) { fprintf(stderr, "kernel_launch: occupancy query says %d blocks per CU\n", per_cu); per_cu = 1; }
        (void)hipGetLastError();
        grid = cus;
    }
    if (grid < 0) return;
    (void)hipMemsetAsync((char*)d_ws + WS_BAR, 0, SZ_BAR + SZ_NS_CNT, stream);
    Params p{};
    for (int i = 0; i < 30; ++i) p.in[i] = (const float*)d_in[i];
    p.out = (float*)d_out; p.ws = (unsigned char*)d_ws;
#if ONE_LAUNCH
    p.ph_lo = 0; p.ph_hi = NPHASE;
    void* args[] = {&p};
    hipError_t e = hipLaunchCooperativeKernel((const void*)mega_fwd, dim3(grid), dim3(NTHREADS), args, LDS_BYTES, stream);
    if (e != hipSuccess) fprintf(stderr, "kernel_launch: cooperative launch failed: %s (grid %d)\n", hipGetErrorString(e), grid);
#else
#ifdef DBG_STOP
    for (int ph = 0; ph <= DBG_STOP; ++ph) { p.ph_lo = ph; p.ph_hi = ph + 1; hipLaunchKernelGGL(mega_fwd, dim3(grid), dim3(NTHREADS), LDS_BYTES, stream, p); }
    p.ph_lo = 99; p.ph_hi = 100; hipLaunchKernelGGL(mega_fwd, dim3(grid), dim3(NTHREADS), LDS_BYTES, stream, p);
#else
    for (int ph = 0; ph < NPHASE; ++ph) {
        p.ph_lo = ph; p.ph_hi = ph + 1;
        hipLaunchKernelGGL(mega_fwd, dim3(grid), dim3(NTHREADS), LDS_BYTES, stream, p);
    }
#endif
#endif
}
```
